# Optimizing an MI355X kernel written in HIP

```python
import jax, jax.numpy as jnp
from jax import lax
import numpy as np

D_MODEL = 1024
BATCH = 4
SEQ = 8192
DEPTH = 2

MEM_LEN = 256
N_EVEN = (DEPTH + 1) // 2
N_ODD = DEPTH // 2
EPS = 1e-6

A_HEADS = 4
A_WIDTH = D_MODEL // 2
HEAD_DIM = A_WIDTH // A_HEADS
IDX_HEADS = 16
IDX_DIM = 64
TOPK_MAX = 256
Q_BLOCK = 128
ROPE_THETA = 500000.0

POOL_WINDOWS = (2, 4, 8, 16)
B_WIDTH = D_MODEL - A_WIDTH
POOL_GROUP = B_WIDTH // len(POOL_WINDOWS)

AB_SIZES = (A_WIDTH, A_WIDTH, A_WIDTH, B_WIDTH, IDX_HEADS * IDX_DIM, IDX_HEADS, IDX_DIM)
IN_AB = sum(AB_SIZES)
AB_SPLITS = [int(s) for s in np.cumsum(AB_SIZES)[:-1]]

D_CONV = D_MODEL
CONV_WIDTH = 31

C_HEADS = 4
C_HEAD_DIM = D_MODEL // C_HEADS

D_FF = -(-8 * D_MODEL // (3 * 256)) * 256

kernel_name = 'hybrid_dsa_pool_conformer_trunk'


def rmsnorm(x, g):
    xf = x.astype(jnp.float32)
    y = xf * lax.rsqrt(jnp.mean(xf * xf, axis=-1, keepdims=True) + EPS)
    return (y * g.astype(jnp.float32)).astype(x.dtype)


def layernorm(x, g, b):
    xf = x.astype(jnp.float32)
    mu = jnp.mean(xf, axis=-1, keepdims=True)
    var = jnp.mean(jnp.square(xf - mu), axis=-1, keepdims=True)
    y = (xf - mu) * lax.rsqrt(var + EPS)
    return (y * g.astype(jnp.float32) + b.astype(jnp.float32)).astype(x.dtype)


def rope_partial(x, pos):
    d = x.shape[-1]
    rot = d // 4
    half = rot // 2
    inv = ROPE_THETA ** (-jnp.arange(half, dtype=jnp.float32) * 2.0 / rot)
    ang = pos.astype(jnp.float32)[:, None] * inv[None, :]
    cos = jnp.cos(ang)[:, None, :]
    sin = jnp.sin(ang)[:, None, :]
    xf = x.astype(jnp.float32)
    x1, x2, rest = xf[..., :half], xf[..., half:rot], xf[..., rot:]
    out = jnp.concatenate([x1 * cos - x2 * sin, x2 * cos + x1 * sin, rest], axis=-1)
    return out.astype(x.dtype)


def dsa_attention(q, k, v, iq, iw, ik):
    bsz, t_len = q.shape[0], q.shape[1]
    topk = min(TOPK_MAX, t_len // 4)
    n_blocks = t_len // Q_BLOCK
    key_pos = jnp.arange(t_len)
    bidx = jnp.arange(bsz)[:, None, None]
    scale = HEAD_DIM ** -0.5

    def block(i):
        start = i * Q_BLOCK
        qb = lax.dynamic_slice_in_dim(q, start, Q_BLOCK, axis=1)
        iqb = lax.dynamic_slice_in_dim(iq, start, Q_BLOCK, axis=1)
        iwb = lax.dynamic_slice_in_dim(iw, start, Q_BLOCK, axis=1)
        qpos = start + jnp.arange(Q_BLOCK)
        s = jnp.einsum('bqhd,bsd->bqhs', iqb, ik).astype(jnp.float32)
        scores = jnp.einsum('bqhs,bqh->bqs', jax.nn.relu(s), iwb.astype(jnp.float32))
        causal = key_pos[None, :] <= qpos[:, None]
        scores = jnp.where(causal[None], scores, -jnp.inf)
        _, idx = lax.top_k(scores, topk)
        valid = idx <= qpos[None, :, None]
        ks = k[bidx, idx]
        vs = v[bidx, idx]
        logits = jnp.einsum('bqhd,bqkhd->bhqk', qb, ks).astype(jnp.float32) * scale
        logits = jnp.where(valid[:, None], logits, -jnp.inf)
        p = jax.nn.softmax(logits, axis=-1).astype(v.dtype)
        return jnp.einsum('bhqk,bqkhd->bqhd', p, vs)

    out = lax.map(block, jnp.arange(n_blocks))
    return jnp.transpose(out, (1, 0, 2, 3, 4)).reshape(q.shape)


def multiscale_pool(u, pool_w):
    t_len = u.shape[1]
    uf = u.astype(jnp.float32)
    cs = jnp.cumsum(uf, axis=1)
    t = jnp.arange(t_len)
    outs = []
    for g, w in enumerate(POOL_WINDOWS):
        sl = slice(g * POOL_GROUP, (g + 1) * POOL_GROUP)
        c = cs[..., sl]
        shifted = jnp.pad(c, ((0, 0), (w, 0), (0, 0)))[:, :t_len]
        cnt = jnp.minimum(t + 1, w).astype(jnp.float32)[None, :, None]
        outs.append((c - shifted) / cnt - uf[..., sl])
    pooled = jnp.stack(outs, axis=2).astype(u.dtype)
    y = jnp.einsum('btgc,gcd->btgd', pooled, pool_w)
    return y.reshape(u.shape)


def mixer_ab(xn, w_in, q_gain, k_gain, pool_w, pool_scale, w_out):
    bsz, t_len, _ = xn.shape
    proj = xn @ w_in
    q, k, v, u, iq, iw, ik = jnp.split(proj, AB_SPLITS, axis=-1)
    pos = jnp.arange(t_len)
    q = rope_partial(rmsnorm(q.reshape(bsz, t_len, A_HEADS, HEAD_DIM), q_gain), pos)
    k = rope_partial(rmsnorm(k.reshape(bsz, t_len, A_HEADS, HEAD_DIM), k_gain), pos)
    v = v.reshape(bsz, t_len, A_HEADS, HEAD_DIM)
    iq = rope_partial(iq.reshape(bsz, t_len, IDX_HEADS, IDX_DIM), pos)
    ik = rope_partial(ik.reshape(bsz, t_len, 1, IDX_DIM), pos)[:, :, 0]
    iw = iw * (IDX_HEADS ** -0.5 * IDX_DIM ** -0.5)
    a = dsa_attention(q, k, v, iq, iw, ik).reshape(bsz, t_len, A_WIDTH)
    b = multiscale_pool(u, pool_w) * pool_scale
    return jnp.concatenate([a, b], axis=-1) @ w_out


def conv_module(xn, w_in, b_in, dw_w, dw_b, ln_g, ln_b, w_out):
    h = xn @ w_in + b_in
    a, gate = jnp.split(h, 2, axis=-1)
    h = a * jax.nn.sigmoid(gate)
    h = lax.conv_general_dilated(
        h, dw_w[:, None, :], window_strides=(1,), padding=[(CONV_WIDTH - 1, 0)],
        dimension_numbers=('NWC', 'WIO', 'NWC'), feature_group_count=D_CONV) + dw_b
    h = jax.nn.silu(layernorm(h, ln_g, ln_b))
    return h @ w_out


def cross_attn(hn, memn, wq, wk, wv, q_gain, k_gain, wo):
    bsz, t_len, _ = hn.shape
    m_len = memn.shape[1]
    q = rmsnorm((hn @ wq).reshape(bsz, t_len, C_HEADS, C_HEAD_DIM), q_gain)
    k = rmsnorm((memn @ wk).reshape(bsz, m_len, C_HEADS, C_HEAD_DIM), k_gain)
    v = (memn @ wv).reshape(bsz, m_len, C_HEADS, C_HEAD_DIM)
    logits = jnp.einsum('bthd,bmhd->bhtm', q, k).astype(jnp.float32) * C_HEAD_DIM ** -0.5
    p = jax.nn.softmax(logits, axis=-1).astype(v.dtype)
    o = jnp.einsum('bhtm,bmhd->bthd', p, v).reshape(bsz, t_len, D_MODEL)
    return o @ wo


def swiglu(xn, w_gate, w_up, w_down):
    return (jax.nn.silu(xn @ w_gate) * (xn @ w_up)) @ w_down


def setup_inputs(seed: int = 0) -> dict:
    key = jax.random.key(seed)
    ks = iter(jax.random.split(key, 40))

    def dense(shape, fan_in):
        return jax.random.normal(next(ks), shape, jnp.float32) * fan_in ** -0.5

    def gain(shape):
        return 1.0 + 0.05 * jax.random.normal(next(ks), shape, jnp.float32)

    def bias(shape):
        return 0.02 * jax.random.normal(next(ks), shape, jnp.float32)

    return {
        'x': jax.random.normal(next(ks), (BATCH, SEQ, D_MODEL), jnp.float32),
        'mem': jax.random.normal(next(ks), (BATCH, MEM_LEN, D_MODEL), jnp.float32),
        'norm_mix': gain((DEPTH, D_MODEL)),
        'norm_cross': gain((DEPTH, D_MODEL)),
        'norm_mem': gain((DEPTH, D_MODEL)),
        'norm_ffn': gain((DEPTH, D_MODEL)),
        'w_in_ab': dense((N_EVEN, D_MODEL, IN_AB), D_MODEL),
        'a_q_norm': gain((N_EVEN, HEAD_DIM)),
        'a_k_norm': gain((N_EVEN, HEAD_DIM)),
        'pool_w': dense((N_EVEN, len(POOL_WINDOWS), POOL_GROUP, POOL_GROUP), POOL_GROUP),
        'pool_scale': gain((N_EVEN, B_WIDTH)),
        'w_out_ab': dense((N_EVEN, D_MODEL, D_MODEL), D_MODEL),
        'conv_w_in': dense((N_ODD, D_MODEL, 2 * D_CONV), D_MODEL),
        'conv_b_in': bias((N_ODD, 2 * D_CONV)),
        'conv_dw_w': dense((N_ODD, CONV_WIDTH, D_CONV), CONV_WIDTH),
        'conv_dw_b': bias((N_ODD, D_CONV)),
        'conv_ln_g': gain((N_ODD, D_CONV)),
        'conv_ln_b': bias((N_ODD, D_CONV)),
        'conv_w_out': dense((N_ODD, D_CONV, D_MODEL), D_CONV),
        'cross_wq': dense((DEPTH, D_MODEL, D_MODEL), D_MODEL),
        'cross_wk': dense((DEPTH, D_MODEL, D_MODEL), D_MODEL),
        'cross_wv': dense((DEPTH, D_MODEL, D_MODEL), D_MODEL),
        'cross_q_norm': gain((DEPTH, C_HEAD_DIM)),
        'cross_k_norm': gain((DEPTH, C_HEAD_DIM)),
        'cross_wo': dense((DEPTH, D_MODEL, D_MODEL), D_MODEL),
        'ffn_w_gate': dense((DEPTH, D_MODEL, D_FF), D_MODEL),
        'ffn_w_up': dense((DEPTH, D_MODEL, D_FF), D_MODEL),
        'ffn_w_down': dense((DEPTH, D_FF, D_MODEL), D_FF),
    }


def reference(x, mem, norm_mix, norm_cross, norm_mem, norm_ffn, w_in_ab, a_q_norm, a_k_norm,
              pool_w, pool_scale, w_out_ab, conv_w_in, conv_b_in, conv_dw_w, conv_dw_b,
              conv_ln_g, conv_ln_b, conv_w_out, cross_wq, cross_wk, cross_wv, cross_q_norm,
              cross_k_norm, cross_wo, ffn_w_gate, ffn_w_up, ffn_w_down):
    h = x
    for l in range(DEPTH):
        xn = rmsnorm(h, norm_mix[l])
        if l % 2 == 0:
            e = l // 2
            h = h + mixer_ab(xn, w_in_ab[e], a_q_norm[e], a_k_norm[e], pool_w[e],
                             pool_scale[e], w_out_ab[e])
        else:
            o = l // 2
            h = h + conv_module(xn, conv_w_in[o], conv_b_in[o], conv_dw_w[o], conv_dw_b[o],
                                conv_ln_g[o], conv_ln_b[o], conv_w_out[o])
        h = h + cross_attn(rmsnorm(h, norm_cross[l]), rmsnorm(mem, norm_mem[l]),
                           cross_wq[l], cross_wk[l], cross_wv[l], cross_q_norm[l],
                           cross_k_norm[l], cross_wo[l])
        h = h + swiglu(rmsnorm(h, norm_ffn[l]), ffn_w_gate[l], ffn_w_up[l], ffn_w_down[l])
    return h
```

```cpp
#include <hip/hip_runtime.h>
#include <cstdio>
#include <cstdint>
__device__ __forceinline__ int lane_id_() { int l; asm volatile("v_mbcnt_lo_u32_b32 %0, -1, 0\n\tv_mbcnt_hi_u32_b32 %0, -1, %0" : "=v"(l)); return l; }
__device__ __forceinline__ int otid(int wave) { return wave * 64 + lane_id_(); }
namespace pg8 {
#define PG8_LAS __attribute__((address_space(3)))
typedef unsigned short bf16_t;
typedef short bf16x8 __attribute__((ext_vector_type(8)));
typedef float f32x4 __attribute__((ext_vector_type(4)));
typedef unsigned u32x4 __attribute__((ext_vector_type(4)));
constexpr int BM = 256, BK = 64, HALF = 128, HTB = HALF * BK * 2  , STAGE_BYTES = 8 * HTB, NXCD = 8, WGM = 8;

__host__ __device__ __forceinline__ int lds_byte(int r, int c) { const int st = (r >> 4) * 2 + (c >> 5), rr = r & 15, cc = c & 31, ob = rr * 64 + cc * 2; return st * 1024 + (ob ^ (((ob >> 9) & 1) << 5)); }
__host__ __device__ __forceinline__ void stage_rc(int b, int& R, int& C) { const int st = b / 1024, sb = b % 1024, swz = sb ^ (((sb >> 9) & 1) << 5); R = (st >> 1) * 16 + swz / 64; C = (st & 1) * 32 + (swz % 64) / 2; }
__host__ __device__ __forceinline__ int perm32(int rho) { const int n = rho >> 4, i = rho & 15; return 8 * (i >> 2) + 4 * n + (i & 3); }

struct Unit { int pm, pn; };
struct Gemm { const bf16_t* A; const bf16_t* Bt; int M, N, K; };

struct StaticOrder {
    int nM, nN, nwg, G, c;
    __host__ __device__ void init(int M, int N, int G_, int c_) { nM = M / BM; nN = N / BM; nwg = nM * nN; G = G_; c = c_; }
    __host__ __device__ bool next(int i, Unit& u) const {
        const long L = (long)i * G + c; if (L >= nwg) return false;
        int wgid = (int)L; { const int q = nwg / NXCD, r = nwg % NXCD, xcd = wgid % NXCD, off = wgid / NXCD; wgid = (xcd < r ? xcd * (q + 1) : r * (q + 1) + (xcd - r) * q) + off; }
        const int nig = WGM * nN, gid = wgid / nig, fm = gid * WGM, gsz = (nM - fm) < WGM ? (nM - fm) : WGM;
        u.pm = fm + ((wgid % nig) % gsz); u.pn = (wgid % nig) / gsz; return true;
    }
    __device__ __forceinline__ void a_ready(const Unit&) const {}
    __device__ __forceinline__ void done(const Unit&) const {}
};

__device__ __forceinline__ unsigned cvt_pk_bf16(float lo, float hi) { unsigned r; asm volatile("v_cvt_pk_bf16_f32 %0, %1, %2" : "=v"(r) : "v"(lo), "v"(hi)); return r; }
typedef float f32x2 __attribute__((ext_vector_type(2)));
__device__ __forceinline__ f32x2 gelu_pk(f32x2 v) {
    const f32x2 av = __builtin_elementwise_abs(v), d = av * 0.2316418882f + 1.0f;
    f32x2 t; t.x = __builtin_amdgcn_rcpf(d.x); t.y = __builtin_amdgcn_rcpf(d.y);
    f32x2 q = t * 0.5307027145f + (-0.7265760135f); q = q * t + 0.7107068705f; q = q * t + (-0.142248368f); q = q * t + 0.127414796f; q = q * t;
    const f32x2 s = (v * v) * (-0.72134752044f);
    f32x2 e; e.x = __builtin_amdgcn_exp2f(s.x); e.y = __builtin_amdgcn_exp2f(s.y);
    const f32x2 m = v * (q * e), r = v - m;
    f32x2 o; o.x = v.x < 0.f ? m.x : r.x; o.y = v.y < 0.f ? m.y : r.y; return o;
}

template <int ACT  > struct EpiBf16 {
    static constexpr bool PERM = true, AFTER_DRAIN = false; static_assert(ACT == 0 || ACT == 1, "EpiBf16: ACT is 0 (none) or 1 (gelu_pk)");
    bf16_t* O; int ldc; const float* bias; int split_cols; size_t split_stride; float scale0;
    __device__ __forceinline__ void operator()(const f32x4 (&acc)[2][2][4][2], const Unit& u, int wr, int wc, int fr, int fq) const {
        const int row0 = u.pm * BM + wr * 64 + fr; int colt = u.pn * BM; bf16_t* base = O;
        float sc = 1.f; if (split_cols) { const int t = colt / split_cols; base += (size_t)t * split_stride; colt -= t * split_cols; if (t == 0) sc = scale0; }
        const int col0 = colt + wc * 32 + 8 * fq, bcol0 = u.pn * BM + wc * 32 + 8 * fq;
        f32x4 bv[2][2];
#pragma unroll
        for (int bj = 0; bj < 2; ++bj)
#pragma unroll
            for (int n = 0; n < 2; ++n) bv[bj][n] = bias ? *(const f32x4*)(bias + bcol0 + bj * HALF + 4 * n) : (f32x4){0.f, 0.f, 0.f, 0.f};
#pragma unroll
        for (int ai = 0; ai < 2; ++ai)
#pragma unroll
            for (int m = 0; m < 4; ++m) { bf16_t* rowp = base + (size_t)(row0 + ai * HALF + m * 16) * ldc + col0;
#pragma unroll
                for (int bj = 0; bj < 2; ++bj) { f32x4 v0 = acc[ai][bj][m][0] + bv[bj][0], v1 = acc[ai][bj][m][1] + bv[bj][1];
                    if (ACT == 1) { f32x2 a = gelu_pk((f32x2){v0[0], v0[1]}), b = gelu_pk((f32x2){v0[2], v0[3]}), c = gelu_pk((f32x2){v1[0], v1[1]}), d = gelu_pk((f32x2){v1[2], v1[3]});
                        v0 = (f32x4){a.x, a.y, b.x, b.y}; v1 = (f32x4){c.x, c.y, d.x, d.y}; }
                    v0 = v0 * sc; v1 = v1 * sc; u32x4 w; w.x = cvt_pk_bf16(v0[0], v0[1]); w.y = cvt_pk_bf16(v0[2], v0[3]); w.z = cvt_pk_bf16(v1[0], v1[1]); w.w = cvt_pk_bf16(v1[2], v1[3]);
                    *(u32x4*)(rowp + bj * HALF) = w; } }
    }
};

struct EpiRes {
    static constexpr bool PERM = false, AFTER_DRAIN = false;
    const float* base; float* C; int ldc;
    __device__ __forceinline__ void operator()(const f32x4 (&acc)[2][2][4][2], const Unit& u, int wr, int wc, int fr, int fq) const {
        const int row0 = u.pm * BM + wr * 64 + fr, col0 = u.pn * BM + wc * 32 + 4 * fq;
#pragma unroll
        for (int ai = 0; ai < 2; ++ai)
#pragma unroll
            for (int m = 0; m < 4; ++m) { const size_t off = (size_t)(row0 + ai * HALF + m * 16) * ldc + col0;
                f32x4 bs[2][2];
#pragma unroll
                for (int bj = 0; bj < 2; ++bj)
#pragma unroll
                    for (int n = 0; n < 2; ++n) bs[bj][n] = *(const f32x4*)(base + off + bj * HALF + n * 16);
#pragma unroll
                for (int bj = 0; bj < 2; ++bj)
#pragma unroll
                    for (int n = 0; n < 2; ++n) *(f32x4*)(C + off + bj * HALF + n * 16) = bs[bj][n] + acc[ai][bj][m][n]; }
    }
};
template <int MODE> struct EpiGate {
    static constexpr bool PERM = true, AFTER_DRAIN = false;
    bf16_t* O; int ldc; const float* bias; int NH;
    __device__ __forceinline__ void operator()(const f32x4 (&acc)[2][2][4][2], const Unit& u, int wr, int wc, int fr, int fq) const {
        const int row0 = u.pm * BM + wr * 64 + fr, col0 = u.pn * HALF + wc * 32 + 8 * fq;
        f32x4 bl[2], br[2];
#pragma unroll
        for (int n = 0; n < 2; ++n) { bl[n] = (MODE == 1) ? *(const f32x4*)(bias + col0 + 4 * n) : (f32x4){0.f, 0.f, 0.f, 0.f}; br[n] = (MODE == 1) ? *(const f32x4*)(bias + NH + col0 + 4 * n) : (f32x4){0.f, 0.f, 0.f, 0.f}; }
#pragma unroll
        for (int ai = 0; ai < 2; ++ai)
#pragma unroll
            for (int m = 0; m < 4; ++m) { bf16_t* rowp = O + (size_t)(row0 + ai * HALF + m * 16) * ldc + col0;
                f32x4 v[2];
#pragma unroll
                for (int n = 0; n < 2; ++n) { const f32x4 l = acc[ai][0][m][n] + bl[n], r = acc[ai][1][m][n] + br[n];
#pragma unroll
                    for (int j = 0; j < 4; ++j) {
                        if (MODE == 0) { const float s = __builtin_amdgcn_rcpf(1.0f + __builtin_amdgcn_exp2f(-1.4426950408889634f * l[j])); v[n][j] = l[j] * s * r[j]; }
                        else { const float s = __builtin_amdgcn_rcpf(1.0f + __builtin_amdgcn_exp2f(-1.4426950408889634f * r[j])); v[n][j] = l[j] * s; } } }
                u32x4 w; w.x = cvt_pk_bf16(v[0][0], v[0][1]); w.y = cvt_pk_bf16(v[0][2], v[0][3]); w.z = cvt_pk_bf16(v[1][0], v[1][1]); w.w = cvt_pk_bf16(v[1][2], v[1][3]);
                *(u32x4*)rowp = w; }
    }
};

template <class Epi, class Sched, bool ALIGN_EPI = false, bool SP2 = false>
__device__ __forceinline__ void gemm_phase(PG8_LAS unsigned char* lds, const Gemm g, const Sched& S, const Epi& E, const int wave_) {
    const int tid = otid(wave_), wid = wave_, lane = tid & 63, wr = wid >> 2, wc = wid & 3, fr = lane & 15, fq = lane >> 4;
    const int K = g.K, nt = K / BK;
    unsigned voffA[2], voffB[2];
#pragma unroll
    for (int i = 0; i < 2; ++i) { int R, C; stage_rc(tid * 16 + i * 8192, R, C); const int Rb = Epi::PERM ? ((R & ~31) + perm32(R & 31)) : R;
        voffA[i] = (unsigned)(R * K + C) * 2u; voffB[i] = (unsigned)(Rb * K + C) * 2u; }
    const size_t kstep = (size_t)(BK * 2);
    const size_t hstep = (size_t)HALF * K * 2;
    const size_t tstep = 2 * hstep;
    const unsigned ldsw = (unsigned)wid * 1024u;
    const int aoff = lds_byte(wr * 64 + fr, fq * 8), boff = lds_byte(wc * 32 + fr, fq * 8);
#define PG8_SA(b, h) (((b) * 2 + (h)) * HTB)
#define PG8_SB(b, h) ((4 + (b) * 2 + (h)) * HTB)
#define PG8_STAGE(bufoff, gbase, voff) do { _Pragma("unroll") for (int _i = 0; _i < 2; ++_i) \
        __builtin_amdgcn_global_load_lds((const unsigned*)((const char*)(gbase) + (voff)[_i]), (PG8_LAS unsigned*)(lds + (bufoff) + ldsw + _i * 8192), 16, 0, 0); } while (0)
#define PG8_LDA(dst, b, h) do { _Pragma("unroll") for (int m = 0; m < 4; ++m) _Pragma("unroll") for (int k = 0; k < 2; ++k) dst[m][k] = *(const PG8_LAS bf16x8*)(lds + PG8_SA(b, h) + aoff + m * 2048 + k * 1024); } while (0)
#define PG8_LDB(dst, b, h) do { _Pragma("unroll") for (int n = 0; n < 2; ++n) _Pragma("unroll") for (int k = 0; k < 2; ++k) dst[n][k] = *(const PG8_LAS bf16x8*)(lds + PG8_SB(b, h) + boff + n * 2048 + k * 1024); } while (0)
#define PG8_MMA(ai, bj, At, Bt) do { __builtin_amdgcn_s_setprio(1); _Pragma("unroll") for (int m = 0; m < 4; ++m) _Pragma("unroll") for (int n = 0; n < 2; ++n) _Pragma("unroll") for (int k = 0; k < 2; ++k) \
        acc[ai][bj][m][n] = __builtin_amdgcn_mfma_f32_16x16x32_bf16(Bt[n][k], At[m][k], acc[ai][bj][m][n], 0, 0, 0); __builtin_amdgcn_s_setprio(0); } while (0)
#define PG8_WAIT_V(n) asm volatile("s_waitcnt vmcnt(" #n ")" ::: "memory")
#define PG8_WAIT_L(n) asm volatile("s_waitcnt lgkmcnt(" #n ")" ::: "memory")
#define PG8_BAR __builtin_amdgcn_s_barrier()
#define PG8_SCHED __builtin_amdgcn_sched_barrier(0)
    Unit cur, nxt; int ui = 0;
    if (!S.next(0, cur)) return;
    f32x4 acc[2][2][4][2];
#pragma unroll
    for (int a = 0; a < 2; ++a)
#pragma unroll
        for (int b = 0; b < 2; ++b)
#pragma unroll
            for (int m = 0; m < 4; ++m)
#pragma unroll
                for (int n = 0; n < 2; ++n) acc[a][b][m][n] = (f32x4){0.f, 0.f, 0.f, 0.f};
    bf16x8 At[4][2], B0[2][2], B1[2][2];
    const char* cA = (const char*)g.A + (size_t)cur.pm * tstep; const char* cB = (const char*)g.Bt + (size_t)cur.pn * tstep;
    S.a_ready(cur);
    if constexpr (SP2) {
        PG8_STAGE(PG8_SB(0, 0), cB, voffB); PG8_STAGE(PG8_SB(0, 1), cB + hstep, voffB); PG8_STAGE(PG8_SA(0, 0), cA, voffA); PG8_STAGE(PG8_SA(0, 1), cA + hstep, voffA);
        if (wr == 1) PG8_BAR;
        PG8_WAIT_V(2); PG8_BAR;
        PG8_STAGE(PG8_SB(1, 0), cB + kstep, voffB); PG8_STAGE(PG8_SA(1, 0), cA + kstep, voffA); PG8_STAGE(PG8_SB(1, 1), cB + hstep + kstep, voffB);
        PG8_WAIT_V(6); PG8_BAR;
    } else {
        PG8_STAGE(PG8_SB(0, 0), cB, voffB); PG8_STAGE(PG8_SA(0, 0), cA, voffA); PG8_STAGE(PG8_SB(0, 1), cB + hstep, voffB); PG8_STAGE(PG8_SA(0, 1), cA + hstep, voffA);
        if (wr == 1) PG8_BAR;
        PG8_WAIT_V(4); PG8_BAR;
        PG8_STAGE(PG8_SB(1, 0), cB + kstep, voffB); PG8_STAGE(PG8_SA(1, 0), cA + kstep, voffA); PG8_STAGE(PG8_SB(1, 1), cB + hstep + kstep, voffB);
        PG8_WAIT_V(6); PG8_BAR;
    }
    for (;;) {
        const bool has_next = S.next(ui + 1, nxt);
        const char* nA = has_next ? (const char*)g.A + (size_t)nxt.pm * tstep : cA; const char* nB = has_next ? (const char*)g.Bt + (size_t)nxt.pn * tstep : cB;
        for (int t = 0; t < nt; t += 2) {
            const bool last = (t == nt - 2);
            const char* a1 = cA + (size_t)(t + 1) * kstep;
            const char* a2 = last ? nA : cA + (size_t)(t + 2) * kstep; const char* b2 = last ? nB : cB + (size_t)(t + 2) * kstep;
            const char* a3 = a2 + kstep; const char* b3 = b2 + kstep;
            if (last && has_next) S.a_ready(nxt);
            if constexpr (SP2) {
            PG8_LDB(B0, 0, 0); PG8_LDB(B1, 0, 1); PG8_SCHED; PG8_LDA(At, 0, 0); PG8_STAGE(PG8_SA(1, 1), a1 + hstep, voffA);
            PG8_WAIT_V(8); PG8_WAIT_L(0); PG8_BAR; PG8_MMA(0, 0, At, B0); PG8_MMA(0, 1, At, B1); PG8_BAR; PG8_SCHED;
            PG8_LDA(At, 0, 1); PG8_STAGE(PG8_SB(0, 0), b2, voffB); PG8_STAGE(PG8_SB(0, 1), b2 + hstep, voffB); PG8_STAGE(PG8_SA(0, 0), a2, voffA);
            PG8_WAIT_V(8); PG8_WAIT_L(0); PG8_BAR; PG8_MMA(1, 0, At, B0); PG8_MMA(1, 1, At, B1); PG8_BAR; PG8_SCHED;
            PG8_LDB(B0, 1, 0); PG8_LDB(B1, 1, 1); PG8_SCHED; PG8_LDA(At, 1, 0); PG8_STAGE(PG8_SA(0, 1), a2 + hstep, voffA);
            PG8_WAIT_V(8); PG8_WAIT_L(0); PG8_BAR; PG8_MMA(0, 0, At, B0); PG8_MMA(0, 1, At, B1); PG8_BAR; PG8_SCHED;
            PG8_LDA(At, 1, 1); PG8_STAGE(PG8_SB(1, 0), b3, voffB); PG8_STAGE(PG8_SB(1, 1), b3 + hstep, voffB); PG8_STAGE(PG8_SA(1, 0), a3, voffA);
            PG8_WAIT_V(8); PG8_WAIT_L(0); PG8_BAR; PG8_MMA(1, 0, At, B0); PG8_MMA(1, 1, At, B1); PG8_BAR; PG8_SCHED;
            } else {
            PG8_LDB(B0, 0, 0); PG8_SCHED; PG8_LDA(At, 0, 0); PG8_STAGE(PG8_SA(1, 1), a1 + hstep, voffA);
            PG8_WAIT_L(8); PG8_BAR; PG8_WAIT_L(0); PG8_MMA(0, 0, At, B0); PG8_BAR; PG8_SCHED;
            PG8_LDB(B1, 0, 1); PG8_STAGE(PG8_SB(0, 0), b2, voffB);
            PG8_BAR; PG8_WAIT_L(0); PG8_MMA(0, 1, At, B1); PG8_BAR;
            PG8_LDA(At, 0, 1); PG8_STAGE(PG8_SA(0, 0), a2, voffA);
            PG8_BAR; PG8_WAIT_L(0); PG8_MMA(1, 0, At, B0); PG8_BAR; PG8_SCHED;
            PG8_STAGE(PG8_SB(0, 1), b2 + hstep, voffB);
            PG8_WAIT_V(6); PG8_BAR; PG8_MMA(1, 1, At, B1); PG8_BAR;
            PG8_LDB(B0, 1, 0); PG8_SCHED; PG8_LDA(At, 1, 0); PG8_STAGE(PG8_SA(0, 1), a2 + hstep, voffA);
            PG8_WAIT_L(8); PG8_BAR; PG8_WAIT_L(0); PG8_MMA(0, 0, At, B0); PG8_BAR; PG8_SCHED;
            PG8_LDB(B1, 1, 1); PG8_STAGE(PG8_SB(1, 0), b3, voffB);
            PG8_BAR; PG8_WAIT_L(0); PG8_MMA(0, 1, At, B1); PG8_BAR;
            PG8_LDA(At, 1, 1); PG8_STAGE(PG8_SA(1, 0), a3, voffA);
            PG8_BAR; PG8_WAIT_L(0); PG8_MMA(1, 0, At, B0); PG8_BAR; PG8_SCHED;
            PG8_STAGE(PG8_SB(1, 1), b3 + hstep, voffB);
            PG8_WAIT_V(6); PG8_BAR; PG8_MMA(1, 1, At, B1); PG8_BAR;
            }
        }
        if constexpr (ALIGN_EPI) { if (wr == 0) PG8_BAR; }
        if constexpr (!Epi::AFTER_DRAIN) { E(acc, cur, wr, wc, fr, fq); S.done(cur); }
        if (!has_next) break;
#pragma unroll
        for (int a = 0; a < 2; ++a)
#pragma unroll
            for (int b = 0; b < 2; ++b)
#pragma unroll
                for (int m = 0; m < 4; ++m)
#pragma unroll
                    for (int n = 0; n < 2; ++n) acc[a][b][m][n] = (f32x4){0.f, 0.f, 0.f, 0.f};
        cur = nxt; cA = nA; cB = nB; ++ui;
        if constexpr (ALIGN_EPI) { if (wr == 1) PG8_BAR; }
    }
    PG8_WAIT_V(0);
    if constexpr (!ALIGN_EPI) { if (wr == 0) PG8_BAR; }
    PG8_BAR;
    if constexpr (Epi::AFTER_DRAIN) { E.fused(acc, cur, wr, wc, fr, fq, lds, wid, lane); S.done(cur); }
#undef PG8_SA
#undef PG8_SB
#undef PG8_STAGE
#undef PG8_LDA
#undef PG8_LDB
#undef PG8_MMA
#undef PG8_WAIT_V
#undef PG8_WAIT_L
#undef PG8_BAR
#undef PG8_SCHED
}
}

#define GAS __attribute__((address_space(1)))
#define LAS __attribute__((address_space(3)))
typedef unsigned short bf16;
typedef unsigned v4u __attribute__((ext_vector_type(4)));
typedef float f32x4 __attribute__((ext_vector_type(4)));
typedef short bf16x8 __attribute__((ext_vector_type(8)));
typedef GAS unsigned gu32;
typedef GAS unsigned long long gu64;
#define RLX_AGENT __ATOMIC_RELAXED, __HIP_MEMORY_SCOPE_AGENT
#define LDS_WAIT() asm volatile("s_waitcnt lgkmcnt(0)" ::: "memory")
#define VM_WAIT() asm volatile("s_waitcnt vmcnt(0)" ::: "memory")
__device__ __forceinline__ unsigned long long rt() { return __builtin_amdgcn_s_memrealtime(); }
__device__ __forceinline__ unsigned f2bf(float f) { unsigned u = __builtin_bit_cast(unsigned, f); return (u + 0x7fffu + ((u >> 16) & 1u)) >> 16; }
__device__ __forceinline__ unsigned pk2(float lo, float hi) { return f2bf(lo) | (f2bf(hi) << 16); }

#define XB_TMO      128
#define XB_XCNT(j)  (256  + 64 * (j))
#define XB_XSUB(j)  (1280 + 64 * (j))
#define XB_XGEN(j)  (2304 + 64 * (j))
#define XB_TOP      3328
#define XB_TOPGEN   3392
#define XCD_BAR_WORDS 3456
#define XB_SPIN_CAP (1u << 18)

__device__ __forceinline__ unsigned xb_ld(unsigned* p)              { return __hip_atomic_load(p, __ATOMIC_RELAXED, __HIP_MEMORY_SCOPE_AGENT); }
__device__ __forceinline__ unsigned xb_add(unsigned* p, unsigned v) { return __hip_atomic_fetch_add(p, v, __ATOMIC_RELAXED, __HIP_MEMORY_SCOPE_AGENT); }
__device__ __forceinline__ unsigned xb_xcc_id() { return (unsigned)__builtin_amdgcn_s_getreg((3 << 11) | 20) & 0xFu; }
#define XB_SPIN(cond, bar) do { unsigned _sp = 0; while (cond) { __builtin_amdgcn_s_sleep(1); \
    if ((++_sp & 255u) == 0u) { if (xb_ld(&(bar)[XB_TMO])) break; if (_sp > XB_SPIN_CAP) { atomicAdd(&(bar)[XB_TMO], 1u); break; } } } } while (0)

struct XcdBarrier {
    int wave;
    unsigned* bar; unsigned x;
    volatile LAS unsigned* st;
};

__device__ __forceinline__ XcdBarrier xcd_barrier_post(unsigned* bar, volatile LAS unsigned* st, int wave) {
    XcdBarrier b; b.wave = wave; b.bar = bar; b.x = xb_xcc_id(); b.st = st;
    if (wave == 0 && lane_id_() == 0) (void)xb_add(&bar[XB_XCNT(b.x)], 1u);
    return b;
}
__device__ __forceinline__ void xcd_barrier_complete(unsigned* bar, unsigned x, unsigned& nloc, unsigned& nx) {
    const unsigned G = gridDim.x * gridDim.y * gridDim.z;
    unsigned sum, cnt, mine, sp = 0u;
    for (;;) {
        sum = 0u; cnt = 0u; mine = 0u;
#pragma unroll
        for (unsigned j = 0; j < 16; ++j) { const unsigned c = xb_ld(&bar[XB_XCNT(j)]); sum += c; cnt += (c > 0u) ? 1u : 0u; mine = (j == x) ? c : mine; }
        if (sum == G) break;
        __builtin_amdgcn_s_sleep(1);
        if ((++sp & 255u) == 0u) { if (xb_ld(&bar[XB_TMO])) break; if (sp > XB_SPIN_CAP) { atomicAdd(&bar[XB_TMO], 1u); break; } }
    }
    nloc = mine > 0u ? mine : 1u; nx = cnt > 0u ? cnt : 1u;
}

__device__ __forceinline__ void xcd_barrier(const XcdBarrier& b) {
    asm volatile("s_waitcnt vmcnt(0)" ::: "memory");
    __syncthreads();
    if (b.wave == 0 && lane_id_() == 0) {
        unsigned* bar = b.bar;
        __builtin_amdgcn_s_waitcnt(0);
        unsigned nloc = b.st[0], nx = b.st[1];
        if (nloc == 0u) { xcd_barrier_complete(bar, b.x, nloc, nx); b.st[0] = nloc; b.st[1] = nx; }
        const unsigned old = xb_add(&bar[XB_XSUB(b.x)], 1u);
        const unsigned gen = old / nloc;
        if (old + 1u == (gen + 1u) * nloc) {
            __builtin_amdgcn_fence(__ATOMIC_RELEASE, "agent");
            asm volatile("s_waitcnt vmcnt(0)" ::: "memory");
            const unsigned og = xb_add(&bar[XB_TOP], 1u);
            const unsigned tg = og / nx;
            if (og + 1u == (tg + 1u) * nx) xb_add(&bar[XB_TOPGEN], 1u);
            else XB_SPIN(xb_ld(&bar[XB_TOPGEN]) == tg, bar);
            __builtin_amdgcn_fence(__ATOMIC_ACQUIRE, "agent");
            xb_add(&bar[XB_XGEN(b.x)], 1u);
            asm volatile("s_waitcnt vmcnt(0)" ::: "memory");
        } else {
            XB_SPIN(xb_ld(&bar[XB_XGEN(b.x)]) == gen, bar);
            __builtin_amdgcn_fence(__ATOMIC_ACQUIRE, "agent");
            asm volatile("s_waitcnt vmcnt(0)" ::: "memory");
        }
    }
    __syncthreads();
}

constexpr int NWAVES = 8;
#ifndef DBG_SKIP
#define DBG_SKIP 0
#endif
#ifndef MK_PER_PHASE
#define MK_PER_PHASE 0
#endif
constexpr int BATCH = 4, T = 8192, D = 1024, M = BATCH * T;
constexpr int MEML = 256, MROWS = BATCH * MEML;
constexpr int AW = 512, HD = 128, NIH = 16, IDIM = 64;
constexpr int TOPK = 256;
constexpr int NIN = 3152, NINP = 3328;
constexpr int DFF = 2816, CW = 31, CHD = 256;
constexpr float EPS = 1e-6f;

constexpr size_t MiB = 1u << 20;
constexpr size_t WS_CTL = 0, CTL_ZERO_BYTES = 1 * MiB;
constexpr size_t WS_WIN = 1 * MiB;
constexpr size_t WS_WOUT = 8 * MiB;
constexpr size_t WS_WCIN = 10 * MiB;
constexpr size_t WS_WCOUT = 14 * MiB;
constexpr size_t WS_WCQ = 16 * MiB;
constexpr size_t WS_WCO = 20 * MiB;
constexpr size_t WS_WCKV = 24 * MiB;
constexpr size_t WS_WGU = 32 * MiB;
constexpr size_t WS_WDN = 54 * MiB;
constexpr size_t WS_MEMN = 65 * MiB;
constexpr size_t WS_MKV = 69 * MiB;
constexpr size_t WS_XN = 80 * MiB;
constexpr size_t WS_BM = 144 * MiB;
constexpr size_t WS_PROJ = 176 * MiB;
constexpr size_t PROJ_T = (size_t)M * 256 * 2;
constexpr size_t WS_HID = WS_PROJ;
constexpr size_t WS_CQ = WS_PROJ;
constexpr size_t WS_CO = WS_PROJ + 64 * MiB;
constexpr size_t WS_G = WS_PROJ;
constexpr size_t WS_END = WS_PROJ + 13 * PROJ_T;
constexpr int CW_TMO = 0, CW_BAR = 4096;

constexpr int RING_OFF = 0, RING_BYTES = 131072;
constexpr int LDSCTL_OFF = RING_BYTES, MISC_OFF = LDSCTL_OFF + 320;
constexpr int LDS_BYTES = 147456;

namespace dsa2 {
constexpr int D = 128, LDQ = 256, LDO = 1024, MWT = 8192;
constexpr float THR = 8.f;
constexpr bool WSKIP = false;

constexpr float SCALE = 0.08838834764831845f;
constexpr int NW = 8, QBLK = 32, KVBLK = 64, QB = NW * QBLK;
constexpr int SHM_V = KVBLK * D * 2, SHM_K = KVBLK * D * 2;
constexpr int LDS_BYTES = 2 * SHM_V + 2 * SHM_K + NW * 64 * 4;
typedef short s16x4 __attribute__((ext_vector_type(4)));
typedef float f32x16 __attribute__((ext_vector_type(16)));
typedef unsigned u32x4 __attribute__((ext_vector_type(4)));
template <class A, class Bt> struct same_t { static constexpr bool v = false; };
template <class A> struct same_t<A, A> { static constexpr bool v = true; };

#define KSWZ(row, colB) ((row) * 256 + ((colB) ^ (((row) & 7) << 4)))
#define SBAR() __builtin_amdgcn_sched_barrier(0)
__device__ __forceinline__ int v_st(int k, int c) { const int kk = (k & ~0xC) | ((k & 4) << 1) | ((k & 8) >> 1); return ((kk >> 3) * 4 + (c >> 5)) * 512 + ((kk & 7) * 32 + (c & 31)) * 2; }
__device__ __forceinline__ int v_rd_base(int lane) { return ((lane & 3) << 3) | (((lane >> 2) & 3) << 6) | (((lane >> 4) & 1) << 5) | (((lane >> 5) & 1) << 8); }
constexpr int v_rd_off(int d0, int ks, int half) { return d0 * 512 + ks * 4096 + half * 2048; }
__device__ __forceinline__ int crow(int r, int hi) { return (r & 3) + 8 * (r >> 2) + 4 * hi; }
__device__ __forceinline__ unsigned cvtpk(float lo, float hi) {
    unsigned r; asm volatile("v_cvt_pk_bf16_f32 %0, %1, %2" : "=v"(r) : "v"(lo), "v"(hi)); return r;
}
__device__ __forceinline__ bf16x8 pack8(f32x4 a, f32x4 b) {
    u32x4 w = {cvtpk(a[0], a[1]), cvtpk(a[2], a[3]), cvtpk(b[0], b[1]), cvtpk(b[2], b[3])};
    return *reinterpret_cast<bf16x8*>(&w);
}
template <class T> __device__ __forceinline__ bf16x8 load8(const T* p) {
    if constexpr (same_t<T, float>::v) { return pack8(*(const f32x4*)p, *(const f32x4*)(p + 4)); }
    else { return *reinterpret_cast<const bf16x8*>(p); }
}
__device__ __forceinline__ void mask_tile(f32x16& p0, f32x16& p1, int dq, unsigned W) {
    const float NEG = -__builtin_inff();
#pragma unroll
    for (int r = 0; r < 16; ++r) {
        const int c = (r & 3) + 8 * (r >> 2);
        if ((unsigned)(dq - c) >= W) p0[r] = NEG;
        if ((unsigned)(dq - c - 32) >= W) p1[r] = NEG;
    }
}
__device__ __forceinline__ void mask_bits(f32x16& p0, f32x16& p1, unsigned mh, int hi) {
    const float NEG = -__builtin_inff();
    auto rr = __builtin_amdgcn_permlane32_swap(mh, mh, false, false);
    const unsigned lo = (unsigned)rr[0] >> (4 * hi), hh = (unsigned)rr[1] >> (4 * hi);
#pragma unroll
    for (int r = 0; r < 16; ++r) {
        const int c = (r & 3) + 8 * (r >> 2);
        if (!((lo >> c) & 1u)) p0[r] = NEG;
        if (!((hh >> c) & 1u)) p1[r] = NEG;
    }
}
__device__ __forceinline__ void partialSM_s(f32x16& p0, f32x16& p1, float& m_reg, float& mn, float& alpha, const float SCALE) {
    float pmax = p0[0]; for (int r = 1; r < 16; ++r) pmax = fmaxf(pmax, p0[r]); for (int r = 0; r < 16; ++r) pmax = fmaxf(pmax, p1[r]);
    { auto rr = __builtin_amdgcn_permlane32_swap(__float_as_uint(pmax), __float_as_uint(pmax), false, false);
      pmax = fmaxf(__uint_as_float(rr[0]), __uint_as_float(rr[1])); }
    const float C2 = 1.4426950408889634f * SCALE;
    if (__builtin_expect(__all((pmax - m_reg) * SCALE <= THR), 1)) { mn = m_reg; alpha = 1.f; }
    else { mn = fmaxf(m_reg, pmax); alpha = __builtin_amdgcn_exp2f((m_reg - mn) * C2); m_reg = mn; }
    const float mnL = -mn * C2;
    for (int r = 0; r < 16; ++r) p0[r] = fmaf(p0[r], C2, mnL); for (int r = 0; r < 16; ++r) p1[r] = fmaf(p1[r], C2, mnL);
    for (int r = 0; r < 16; ++r) p0[r] = __builtin_amdgcn_exp2f(p0[r]);
}
__device__ __forceinline__ void partialSM(f32x16& p0, f32x16& p1, float& m_reg, float& mn, float& alpha) { partialSM_s(p0, p1, m_reg, mn, alpha, SCALE); }
__device__ __forceinline__ void finishSM(f32x16& p0, f32x16& p1, float alpha, float& l_reg, bf16x8& pa0, bf16x8& pa1, bf16x8& pa2, bf16x8& pa3) {
    for (int r = 0; r < 16; ++r) p1[r] = __builtin_amdgcn_exp2f(p1[r]);
    float ps = 0; for (int r = 0; r < 16; ++r) ps += p0[r]; for (int r = 0; r < 16; ++r) ps += p1[r];
    { auto rr = __builtin_amdgcn_permlane32_swap(__float_as_uint(ps), __float_as_uint(ps), false, false);
      ps = __uint_as_float(rr[0]) + __uint_as_float(rr[1]); }
    l_reg = l_reg * alpha + ps;
#define PK4(P, B_, OUT) do { unsigned a0 = cvtpk(P[B_+0], P[B_+1]), a1 = cvtpk(P[B_+2], P[B_+3]);                          \
        unsigned b0 = cvtpk(P[B_+4], P[B_+5]), b1 = cvtpk(P[B_+6], P[B_+7]);                                             \
        auto r0 = __builtin_amdgcn_permlane32_swap(a0, b0, false, false); auto r1 = __builtin_amdgcn_permlane32_swap(a1, b1, false, false); \
        u32x4 w = {r0[0], r1[0], r0[1], r1[1]}; OUT = *reinterpret_cast<bf16x8*>(&w); } while (0)
    PK4(p0, 0, pa0); PK4(p0, 8, pa1); PK4(p1, 0, pa2); PK4(p1, 8, pa3);
#undef PK4
}
template <int KB, bool SK>
__device__ __forceinline__ void qkt(f32x16& p0, f32x16& p1, const char* K_lds, int r32, int hi, const bf16x8* qr, bool act) {
    if (SK && !act) { const float NEG = -__builtin_inff();
#pragma unroll
        for (int r = 0; r < 16; ++r) { p0[r] = NEG; p1[r] = NEG; } return; }
    p0 = f32x16{}; p1 = f32x16{};
    const char* kb[4];
#pragma unroll
    for (int dd = 0; dd < 4; ++dd) kb[dd] = K_lds + KB * SHM_K + KSWZ(r32, (dd * 16 + hi * 8) * 2);
#pragma unroll
    for (int d0 = 0; d0 < 8; ++d0) { const char* a = kb[d0 & 3] + (d0 >> 2) * 128;
        bf16x8 b0 = *reinterpret_cast<const bf16x8*>(a);
        bf16x8 b1 = *reinterpret_cast<const bf16x8*>(a + 32 * 256);
        p0 = __builtin_amdgcn_mfma_f32_32x32x16_bf16(b0, qr[d0], p0, 0, 0, 0);
        p1 = __builtin_amdgcn_mfma_f32_32x32x16_bf16(b1, qr[d0], p1, 0, 0, 0); }
}
template <int VB, bool SK>
__device__ __forceinline__ void pv_tile(f32x16* o, int vb0, bf16x8 pa0, bf16x8 pa1, bf16x8 pa2, bf16x8 pa3, bool act) {
    if (SK && !act) return;
#define TRRD(dst, off) asm volatile("ds_read_b64_tr_b16 %0, %1 offset:%2" : "=&v"(dst) : "v"(vb0), "i"(off) : "memory")
#define PV_D0(d0) do { s16x4 l0, l1, l2, l3, h0, h1, h2, h3; constexpr int b_ = VB * SHM_V + v_rd_off(d0, 0, 0);     \
        TRRD(l0, b_); TRRD(h0, b_ + 2048); TRRD(l1, b_ + 4096); TRRD(h1, b_ + 6144); TRRD(l2, b_ + 8192); TRRD(h2, b_ + 10240); TRRD(l3, b_ + 12288); TRRD(h3, b_ + 14336); \
        asm volatile("s_waitcnt lgkmcnt(0)" ::: "memory"); SBAR();                 \
        o[d0] = __builtin_amdgcn_mfma_f32_32x32x16_bf16(pa0, (bf16x8){l0[0], l0[1], l0[2], l0[3], h0[0], h0[1], h0[2], h0[3]}, o[d0], 0, 0, 0);   \
        o[d0] = __builtin_amdgcn_mfma_f32_32x32x16_bf16(pa1, (bf16x8){l1[0], l1[1], l1[2], l1[3], h1[0], h1[1], h1[2], h1[3]}, o[d0], 0, 0, 0);   \
        o[d0] = __builtin_amdgcn_mfma_f32_32x32x16_bf16(pa2, (bf16x8){l2[0], l2[1], l2[2], l2[3], h2[0], h2[1], h2[2], h2[3]}, o[d0], 0, 0, 0);   \
        o[d0] = __builtin_amdgcn_mfma_f32_32x32x16_bf16(pa3, (bf16x8){l3[0], l3[1], l3[2], l3[3], h3[0], h3[1], h3[2], h3[3]}, o[d0], 0, 0, 0); } while (0)
    PV_D0(0); PV_D0(1); PV_D0(2); PV_D0(3);
#undef PV_D0
#undef TRRD
}

template <class TIn, class TOut> struct BlockRef { const TIn* Q; const TIn* K; const TIn* V; TOut* O; const unsigned long long* MW; int P0; };
template <class TIn> struct Seam {
    bf16x8 qr[8];
    bf16x8 st_k0, st_k1;
    f32x4 tq[1];
};
__device__ __forceinline__ int swa_jlo(int P0, int W) { const int lowk = P0 - W + 1; return lowk > 0 ? lowk / KVBLK : 0; }
#define ROW(p, k0, rr) ((p) + (size_t)((k0) + (rr)) * LDQ + sc)
#define VMW() asm volatile("s_waitcnt vmcnt(0)" ::: "memory")
#define VMWN(n) asm volatile("s_waitcnt vmcnt(%0)" :: "i"(n) : "memory")
#define SLOAD_H(Kp, Vp, k0) do { S.st_v0 = load8<TIn>(ROW(Vp, k0, sr)); S.st_v1 = load8<TIn>(ROW(Vp, k0, 32 + sr));              \
                         S.st_k0 = load8<TIn>(ROW(Kp, k0, sr)); S.st_k1 = load8<TIn>(ROW(Kp, k0, 32 + sr)); } while (0)
#define SWRITE_HK(bf) do { *(bf16x8*)(K_lds + (bf) * SHM_K + kws) = S.st_k0; *(bf16x8*)(K_lds + (bf) * SHM_K + kws + 32 * 256) = S.st_k1; } while (0)
#define SWRITE_HV(bf) do { *(bf16x8*)(V_lds + (bf) * SHM_V + vst0) = S.st_v0; *(bf16x8*)(V_lds + (bf) * SHM_V + vst1) = S.st_v1; } while (0)
#define SWRITE_H(bf) do { SWRITE_HV(bf); SWRITE_HK(bf); } while (0)
#define SLOAD_F(p, k0) do { S.st_k0 = load8<TIn>(ROW(p, k0, sr)); S.st_k1 = load8<TIn>(ROW(p, k0, 32 + sr)); } while (0)
#define SWRITE_KF(bf) do { *(bf16x8*)(K_lds + (bf) * SHM_K + kws) = S.st_k0; *(bf16x8*)(K_lds + (bf) * SHM_K + kws + 32 * 256) = S.st_k1; } while (0)
#define SWRITE_VF(bf) do { *(bf16x8*)(V_lds + (bf) * SHM_V + vst0) = S.st_k0; *(bf16x8*)(V_lds + (bf) * SHM_V + vst1) = S.st_k1; } while (0)
template <class TIn, class TOut>
__device__ __forceinline__ void causal_swa_prime(const BlockRef<TIn, TOut>& cur, int W, char* lds, Seam<TIn>& S, const int wave_) {
    constexpr bool F32 = same_t<TIn, float>::v; constexpr bool TWOPH = true; static_assert(!F32, "bf16 K/V only");
    const int tid = otid(wave_), wid = wave_, lane = tid & 63, r32 = lane & 31, hi = lane >> 5;
    const int sr = tid >> 4, sc = (tid & 15) * 8, kws = KSWZ(sr, sc * 2); char* K_lds = lds + 2 * SHM_V;
    const int kb0 = swa_jlo(cur.P0, W) * KVBLK;
    for (int d0 = 0; d0 < 8; ++d0) S.qr[d0] = load8<TIn>(cur.Q + (size_t)(wid * QBLK + r32) * LDQ + d0 * 16 + hi * 8);
    if constexpr (TWOPH) { SLOAD_F((cur.K), kb0); VMW(); SWRITE_KF(0); SBAR(); SLOAD_F((cur.V), kb0); }
    else { SLOAD_H(cur.K, cur.V, kb0); VMW(); SWRITE_HK(0); }
    __syncthreads();
}
template <class TIn, class TOut>
__device__ __forceinline__ void causal_swa_block(const BlockRef<TIn, TOut>& cur, const BlockRef<TIn, TOut>& nxt, int skv, int W, char* lds, Seam<TIn>& S, const int wave_) {
    constexpr bool F32 = same_t<TIn, float>::v;
    const int tid = otid(wave_), wid = wave_, lane = tid & 63, r32 = lane & 31, hi = lane >> 5;
    const int j_lo = swa_jlo(cur.P0, W);
    int j_hi = (cur.P0 + QB - 1) / KVBLK + 1; if (j_hi > skv / KVBLK) j_hi = skv / KVBLK;
    const int NT = j_hi - j_lo;
    const int kbn = swa_jlo(nxt.P0, W) * KVBLK;
    const int qlo = cur.P0 + wid * QBLK, qm = qlo + r32 - 4 * hi;
    char* V_lds = lds; char* K_lds = lds + 2 * SHM_V;
    float* ws = (float*)(lds + 2 * SHM_V + 2 * SHM_K) + wid * 64; float* li_l = ws, * al_l = ws + 32;
    float m_reg = -1e30f, l_reg = 0; f32x16 o[4] = {};
    const int sr = tid >> 4, sc = (tid & 15) * 8, vst0 = v_st(sr, sc), vst1 = v_st(32 + sr, sc), kws = KSWZ(sr, sc * 2);
    const int vb0 = (int)(uintptr_t)V_lds + v_rd_base(lane);
    const TIn* Kh = cur.K; const TIn* Vh = cur.V;
#define RESC(a) do { if (__any((a) < 1.f)) { if (hi == 0) al_l[r32] = (a); asm volatile("s_waitcnt lgkmcnt(0)" ::: "memory");              \
                     for (int d_ = 0; d_ < 4; ++d_) for (int r = 0; r < 16; ++r) o[d_][r] *= al_l[crow(r, hi)]; } } while (0)
#define KBASE(t) ((j_lo + (t)) * KVBLK)
#define ACT(t) (KBASE(t) <= qlo + QBLK - 1 && KBASE(t) + KVBLK - 1 >= qlo - W + 1)
#define MASKT(P0_, P1_, t, MWX) do { mask_bits(P0_, P1_, MWX, hi); } while (0)
#define MWLD(t) (((const unsigned*)cur.MW)[((size_t)(j_lo + (t)) * MWT + qlo + r32) * 2 + hi])
    constexpr int NQL = F32 ? 16 : 8; constexpr bool TWOPH = true;
    constexpr bool SK = WSKIP && !F32;
#define SEAM_K0() do { VMWN(NQL); if constexpr (TWOPH) { SWRITE_KF(0); SBAR(); SLOAD_F((nxt.V), kbn); } else { SWRITE_HK(0); } SBAR(); } while (0)
    f32x16 pA0, pA1, pB0, pB1; float mnA, mnB, alA, alB; bf16x8 pa0, pa1, pa2, pa3;
    if constexpr (TWOPH) { VMW(); SWRITE_VF(0); SBAR(); } else { SWRITE_HV(0); SBAR(); }
    if (NT > 1) { if constexpr (TWOPH) SLOAD_F((Kh), KBASE(1)); else SLOAD_H(Kh, Vh, KBASE(1)); }
    unsigned mwA = MWLD(0); SBAR();     qkt<0, SK>(pA0, pA1, K_lds, r32, hi, S.qr, ACT(0));
    if constexpr (TWOPH) { if (NT > 1) { VMW(); SWRITE_KF(1); SBAR(); SLOAD_F((Vh), KBASE(1)); } }
    MASKT(pA0, pA1, 0, mwA); partialSM(pA0, pA1, m_reg, mnA, alA);
    if (NT > 1) { VMW(); if constexpr (TWOPH) { SWRITE_VF(1); SBAR(); if (NT > 2) SLOAD_F((Kh), KBASE(2)); } else SWRITE_H(1); }
    __syncthreads();
#define HALF_STEP(PX0, PX1, mnX, alX, PY0, PY1, alY, t, KB, VB, SB, MWX) do {                                                 \
        MWX = MWLD(t); SBAR(); qkt<KB, SK>(PX0, PX1, K_lds, r32, hi, S.qr, ACT(t));                              \
        finishSM(PY0, PY1, alY, l_reg, pa0, pa1, pa2, pa3); SBAR();                                                           \
        if ((t) + 1 < NT) { if constexpr (TWOPH) { VMW(); SWRITE_KF(SB); SBAR(); SLOAD_F((Vh), KBASE((t) + 1)); }  \
                            else { SLOAD_H(Kh, Vh, KBASE((t) + 1)); } SBAR(); }                                               \
        pv_tile<VB, SK>(o, vb0, pa0, pa1, pa2, pa3, ACT((t) - 1)); MASKT(PX0, PX1, (t), MWX); partialSM(PX0, PX1, m_reg, mnX, alX);                                        \
        __syncthreads();                                                                                                      \
        if ((t) + 1 < NT) { VMW(); if constexpr (TWOPH) { SWRITE_VF(SB); SBAR(); if ((t) + 2 < NT) SLOAD_F((Kh), KBASE((t) + 2)); } \
                            else { SWRITE_H(SB); } }                                                                          \
        RESC(alX); __syncthreads(); } while (0)
    for (int t = 1; t + 1 < NT; t += 2) {
        HALF_STEP(pB0, pB1, mnB, alB, pA0, pA1, alA, t, 1, 0, 0, mwA);
        HALF_STEP(pA0, pA1, mnA, alA, pB0, pB1, alB, t + 1, 0, 1, 1, mwA);
    }
    const bool even = (NT & 1) == 0;
    if (even) { mwA = MWLD(NT - 1); SBAR(); qkt<1, SK>(pB0, pB1, K_lds, r32, hi, S.qr, ACT(NT - 1)); SBAR(); }
#define QROW(e) (nxt.Q + (size_t)(wid * QBLK + r32) * LDQ + ((e) >> 1) * 16 + hi * 8 + ((e) & 1) * 4)
    if constexpr (F32) { SBAR();
#pragma unroll
        for (int e = 0; e < 8; ++e) S.tq[e] = *(const f32x4*)QROW(e); }
    else { SLOAD_F((nxt.K), kbn); SBAR();
#pragma unroll
        for (int d0 = 0; d0 < 8; ++d0) S.qr[d0] = load8<TIn>(nxt.Q + (size_t)(wid * QBLK + r32) * LDQ + d0 * 16 + hi * 8); }
    SBAR();
    finishSM(pA0, pA1, alA, l_reg, pa0, pa1, pa2, pa3); SBAR();
    if constexpr (F32) {
#pragma unroll
        for (int e = 8; e < 16; ++e) S.tq[e] = *(const f32x4*)QROW(e); SBAR(); }
#undef QROW
    pv_tile<0, SK>(o, vb0, pa0, pa1, pa2, pa3, ACT(even ? NT - 2 : NT - 1));
    if (even) { MASKT(pB0, pB1, NT - 1, mwA); partialSM(pB0, pB1, m_reg, mnB, alB); __syncthreads(); RESC(alB);
        finishSM(pB0, pB1, alB, l_reg, pa0, pa1, pa2, pa3); SBAR(); pv_tile<1, SK>(o, vb0, pa0, pa1, pa2, pa3, ACT(NT - 1)); }
    SBAR(); SEAM_K0();
    if (hi == 0) li_l[r32] = l_reg; asm volatile("s_waitcnt lgkmcnt(0)" ::: "memory");
    float rli[16];
#pragma unroll
    for (int r = 0; r < 16; ++r) rli[r] = __builtin_amdgcn_rcpf(li_l[crow(r, hi)]);
    TOut* Ow = cur.O + (size_t)(wid * QBLK) * LDO;
#pragma unroll
    for (int r = 0; r < 16; ++r) { const int orow = crow(r, hi);
#pragma unroll
        for (int d0 = 0; d0 < 4; ++d0) { const float v = o[d0][r] * rli[r];
            if constexpr (same_t<TOut, float>::v) { Ow[(size_t)orow * LDO + d0 * 32 + r32] = v; }
            else { const float vn = __shfl_xor(v, 1);
                   if ((r32 & 1) == 0) *(unsigned*)(Ow + (size_t)orow * LDO + d0 * 32 + r32) = cvtpk(v, vn); } } }
    if constexpr (F32) {
#pragma unroll
        for (int d0 = 0; d0 < 8; ++d0) S.qr[d0] = pack8(S.tq[2 * d0], S.tq[2 * d0 + 1]); }
    __syncthreads();
#undef RESC
#undef KBASE
#undef ACT
#undef MASKT
#undef MWLD
#undef SEAM_K0
#undef HALF_STEP
}
#undef ROW
#undef VMW
#undef VMWN
#undef SLOAD_H
#undef SWRITE_HK
#undef SWRITE_HV
#undef SWRITE_H
#undef SLOAD_F
#undef SWRITE_KF
#undef SWRITE_VF


}

typedef float f32x16 __attribute__((ext_vector_type(16)));
typedef unsigned long long u64;
struct Frame {
    LAS unsigned char* lds;
    volatile LAS unsigned* MISC;
    gu32* ctl;
    int tid, lane, wave, G;
};
__device__ __forceinline__ float wave_sum(float v) {
#pragma unroll
    for (int o = 1; o < 64; o <<= 1) v += __shfl_xor(v, o);
    return v;
}
__device__ __forceinline__ int wave_sum_i(int v) {
#pragma unroll
    for (int o = 1; o < 64; o <<= 1) v += __shfl_xor(v, o);
    return __builtin_amdgcn_readfirstlane(v);
}
__device__ __forceinline__ float bf_lo(unsigned u) { return __uint_as_float(u << 16); }
__device__ __forceinline__ float bf_hi(unsigned u) { return __uint_as_float(u & 0xffff0000u); }

__device__ __forceinline__ void tr_item(const float* W, int ldw, int nvalid, int k0, int n0, bf16* WT, int ldk, int drow0, int kcol0, LAS float* scr, int lane) {
    const int nn = n0 + (lane & 31); const bool ok = nn < nvalid;
#pragma unroll 8
    for (int i = 0; i < 32; ++i) { const int kk = 2 * i + (lane >> 5); scr[kk * 33 + (lane & 31)] = ok ? W[(size_t)(k0 + kk) * ldw + nn] : 0.f; }
    LDS_WAIT(); asm volatile("" ::: "memory");
    const int c = lane & 7;
#pragma unroll
    for (int j = 0; j < 4; ++j) { const int n = (lane >> 3) + 8 * j; const LAS float* s = scr + (8 * c) * 33 + n;
        v4u o; o.x = pk2(s[0 * 33], s[1 * 33]); o.y = pk2(s[2 * 33], s[3 * 33]); o.z = pk2(s[4 * 33], s[5 * 33]); o.w = pk2(s[6 * 33], s[7 * 33]);
        *(GAS v4u*)(WT + (size_t)(drow0 + n) * ldk + kcol0 + k0 + 8 * c) = o; }
    LDS_WAIT(); asm volatile("" ::: "memory");
}
__device__ __forceinline__ void rms_row_to_bf16(int lane, const float* xrow, const float* gain, bf16* orow) {
    const GAS f32x4* xr = (const GAS f32x4*)xrow + lane; const GAS f32x4* gr = (const GAS f32x4*)gain + lane;
    f32x4 v[4]; float s = 0.f;
#pragma unroll
    for (int j = 0; j < 4; ++j) { v[j] = xr[64 * j]; s += (v[j].x * v[j].x + v[j].y * v[j].y) + (v[j].z * v[j].z + v[j].w * v[j].w); }
    const float r = 1.f / sqrtf(wave_sum(s) * (1.f / D) + EPS);
    GAS u64* o8 = (GAS u64*)orow + lane;
#pragma unroll
    for (int j = 0; j < 4; ++j) { const f32x4 g = gr[64 * j]; o8[64 * j] = (u64)pk2(v[j].x * r * g.x, v[j].y * r * g.y) | ((u64)pk2(v[j].z * r * g.z, v[j].w * r * g.w) << 32); }
}
struct P0Args { const float *x, *mem, *norm_mix, *norm_mem, *w_in_ab, *pool_w, *pool_scale, *w_out_ab, *conv_w_in, *conv_w_out, *cross_wq, *cross_wk, *cross_wv, *cross_wo, *ffn_w_gate, *ffn_w_up, *ffn_w_down; unsigned char* ws; };
__device__ __forceinline__ void p0_prologue(Frame& F, const P0Args& a) {
    LAS float* scr = (LAS float*)(F.lds + RING_OFF + F.wave * 16384);
    const int gw = blockIdx.x * NWAVES + F.wave, NGW = F.G * NWAVES, lane = otid(F.wave) & 63;
    unsigned char* ws = a.ws;
    constexpr int I_IN = 16 * (NINP / 32), I_OUTA = 8 * 32, I_CIN = 16 * 64, I_SQ = 16 * 32, I_GU = 16 * (DFF / 32), I_DN = (DFF / 64) * 32;
    constexpr int NITEMS = I_IN + I_OUTA + I_CIN + I_SQ + 8 * I_SQ + 4 * I_GU + 2 * I_DN;
    for (int it = gw; it < NITEMS; it += NGW) {
        int r = it;
        if (r < I_IN) { const int nb = NINP / 32, kb = r / nb, n0 = 32 * (r % nb); tr_item(a.w_in_ab, NIN, NIN, 64 * kb, n0, (bf16*)(ws + WS_WIN), D, n0, 0, scr, lane); continue; } r -= I_IN;
        if (r < I_OUTA) { const int kb = r / 32, n0 = 32 * (r % 32); tr_item(a.w_out_ab, D, D, 64 * kb, n0, (bf16*)(ws + WS_WOUT), D, n0, 0, scr, lane); continue; } r -= I_OUTA;
        if (r < I_CIN) { const int kb = r / 64, n0 = 32 * (r % 64), c = n0 & 1023, dr = 256 * (c >> 7) + (c & 127) + ((n0 >> 10) << 7); tr_item(a.conv_w_in, 2 * D, 2 * D, 64 * kb, n0, (bf16*)(ws + WS_WCIN), D, dr, 0, scr, lane); continue; } r -= I_CIN;
        if (r < I_SQ) { const int kb = r / 32, n0 = 32 * (r % 32); tr_item(a.conv_w_out, D, D, 64 * kb, n0, (bf16*)(ws + WS_WCOUT), D, n0, 0, scr, lane); continue; } r -= I_SQ;
        if (r < 8 * I_SQ) { const int mi = r / I_SQ, l = mi >> 2, which = mi & 3, q = r % I_SQ, kb = q / 32, n0 = 32 * (q % 32);
            const float* src = (which == 0 ? a.cross_wq : which == 1 ? a.cross_wk : which == 2 ? a.cross_wv : a.cross_wo) + (size_t)l * D * D;
            bf16* dst = which == 0 ? (bf16*)(ws + WS_WCQ) + (size_t)l * D * D : which == 3 ? (bf16*)(ws + WS_WCO) + (size_t)l * D * D : (bf16*)(ws + WS_WCKV) + (size_t)l * 2 * D * D + (which == 2 ? (size_t)D * D : 0);
            tr_item(src, D, D, 64 * kb, n0, dst, D, n0, 0, scr, lane); continue; } r -= 8 * I_SQ;
        if (r < 4 * I_GU) { const int mi = r / I_GU, l = mi >> 1, up = mi & 1, q = r % I_GU, nb = DFF / 32, kb = q / nb, n0 = 32 * (q % nb), dr = 256 * (n0 >> 7) + (n0 & 127) + 128 * up;
            const float* src = (up ? a.ffn_w_up : a.ffn_w_gate) + (size_t)l * D * DFF;
            tr_item(src, DFF, DFF, 64 * kb, n0, (bf16*)(ws + WS_WGU) + (size_t)l * 2 * DFF * D, D, dr, 0, scr, lane); continue; } r -= 4 * I_GU;
        { const int l = r / I_DN, q = r % I_DN, kb = q / 32, n0 = 32 * (q % 32);
            tr_item(a.ffn_w_down + (size_t)l * DFF * D, D, D, 64 * kb, n0, (bf16*)(ws + WS_WDN) + (size_t)l * D * DFF, DFF, n0, 0, scr, lane); }
    }
    for (int it = gw; it < 512 * 16; it += NGW) {
        const int cc = it >> 4, n = (it & 15) * 64 + lane, g = cc >> 7;
        const float* pw = a.pool_w + (size_t)cc * 128; const float* ps = a.pool_scale + g * 128; const float* wo = a.w_out_ab + (size_t)(512 + g * 128) * D + n;
        float acc = 0.f;
#pragma unroll 8
        for (int d = 0; d < 128; ++d) acc += (pw[d] * ps[d]) * wo[(size_t)d * D];
        ((bf16*)(ws + WS_WOUT))[(size_t)n * D + 512 + cc] = (bf16)f2bf(acc);
    }
    for (int m = gw; m < M; m += NGW) rms_row_to_bf16(lane, a.x + (size_t)m * D, a.norm_mix, (bf16*)(ws + WS_XN) + (size_t)m * D);
    for (int m = gw; m < 2 * MROWS; m += NGW) { const int l = m / MROWS, r = m % MROWS; rms_row_to_bf16(lane, a.mem + (size_t)r * D, a.norm_mem + l * D, (bf16*)(ws + WS_MEMN) + (size_t)m * D); }
}
__device__ __forceinline__ void norm_phase(Frame& F, const float* H, const float* gain, bf16* XN) {
    const int gw = blockIdx.x * NWAVES + F.wave, NGW = F.G * NWAVES, lane = otid(F.wave) & 63;
    for (int m = gw; m < M; m += NGW) rms_row_to_bf16(lane, H + (size_t)m * D, gain, XN + (size_t)m * D);
}

__device__ const double ROPE_INV16[16] = { 0.15915494309189535, 0.0700865215877985, 0.03086376340470123, 0.013591370636193905, 0.005985185712713705, 0.002635675898667414, 0.001160663641240061, 0.0005111175045375439,
    0.00022507907903927653, 9.911730936901935e-05, 4.364795279280289e-05, 1.9221100684944863e-05, 8.464330808241401e-06, 3.727408601915352e-06, 1.6414262627950345e-06, 7.228293068832865e-07 };
__device__ __forceinline__ void rope_cs(int t, int d16, float& c, float& s) {
    const double rev = (double)t * ROPE_INV16[d16]; const float f = (float)(rev - __builtin_floor(rev));
    c = __builtin_amdgcn_cosf(f); s = __builtin_amdgcn_sinf(f);
}
struct P2Args { const float *a_q_norm, *a_k_norm, *cross_k_norm; unsigned char* ws; };
__device__ __forceinline__ void p2_post(Frame& F, const P2Args& a) {
    const int gw = blockIdx.x * NWAVES + F.wave, NGW = F.G * NWAVES, lane = otid(F.wave) & 63;
    unsigned char* ws = a.ws;
    const float2 gq = *(const float2*)(a.a_q_norm + 2 * lane), gk = *(const float2*)(a.a_k_norm + 2 * lane);
    for (int m = gw; m < M; m += NGW) {
        const int t = m & (T - 1);
        float c0, s0, c1, s1; rope_cs(t, 2 * (lane & 7), c0, s0); rope_cs(t, 2 * (lane & 7) + 1, c1, s1);
#pragma unroll
        for (int i = 0; i < 8; ++i) {
            unsigned* p = (unsigned*)(ws + WS_PROJ + (size_t)(i >> 1) * PROJ_T) + (size_t)m * 128 + (i & 1) * 64 + lane;
            const unsigned u = *p; float x0 = bf_lo(u), x1 = bf_hi(u);
            const float r = 1.f / sqrtf(wave_sum(x0 * x0 + x1 * x1) * (1.f / 128.f) + EPS);
            const float2 g = (i < 4) ? gq : gk; x0 *= r * g.x; x1 *= r * g.y;
            const float o0 = __shfl_xor(x0, 8), o1 = __shfl_xor(x1, 8);
            if (lane < 8) { x0 = x0 * c0 - o0 * s0; x1 = x1 * c1 - o1 * s1; }
            else if (lane < 16) { x0 = x0 * c0 + o0 * s0; x1 = x1 * c1 + o1 * s1; }
            *p = pk2(x0, x1);
        }
        float ic0, is0, ic1, is1; rope_cs(t, 4 * (lane & 3), ic0, is0); rope_cs(t, 4 * (lane & 3) + 2, ic1, is1);
        const int l32 = lane & 31;
#pragma unroll
        for (int i = 0; i < 9; ++i) {
            if (i == 8 && lane >= 32) break;
            unsigned* p = (i < 8) ? (unsigned*)(ws + WS_PROJ + (size_t)(8 + (i >> 1)) * PROJ_T) + (size_t)m * 128 + (i & 1) * 64 + lane
                                  : (unsigned*)(ws + WS_PROJ + (size_t)12 * PROJ_T) + (size_t)m * 128 + 8 + lane;
            if (l32 < 8) { const unsigned u = *p; float x0 = bf_lo(u), x1 = bf_hi(u);
                const float o0 = __shfl_xor(x0, 4), o1 = __shfl_xor(x1, 4);
                if (l32 < 4) { x0 = x0 * ic0 - o0 * is0; x1 = x1 * ic1 - o1 * is1; } else { x0 = x0 * ic0 + o0 * is0; x1 = x1 * ic1 + o1 * is1; }
                *p = pk2(x0, x1); }
        }
#pragma unroll
        for (int g = 0; g < 4; ++g) {
            const int w = 2 << g, cnt = (t + 1 < w) ? t + 1 : w;
            const unsigned* up = (const unsigned*)(ws + WS_PROJ + (size_t)(6 + (g >> 1)) * PROJ_T) + (size_t)m * 128 + (g & 1) * 64 + lane;
            float a0 = 0.f, a1 = 0.f, s0v = 0.f, s1v = 0.f;
            for (int j = 0; j < cnt; ++j) { const unsigned u = up[-(ptrdiff_t)j * 128]; const float x0 = bf_lo(u), x1 = bf_hi(u); if (j == 0) { s0v = x0; s1v = x1; } a0 += x0; a1 += x1; }
            const float ic = 1.f / (float)cnt;
            ((unsigned*)(ws + WS_XN))[(size_t)m * 512 + 256 + g * 64 + lane] = pk2(a0 * ic - s0v, a1 * ic - s1v);
        }
    }
    for (int it = gw; it < 2 * MROWS * 4; it += NGW) {
        const int l = it / (MROWS * 4), r = (it >> 2) % MROWS, h = it & 3;
        u64* p = (u64*)((bf16*)(ws + WS_MKV) + ((size_t)l * MROWS + r) * 2048 + h * 256) + lane;
        const u64 u = *p; float x0 = bf_lo((unsigned)u), x1 = bf_hi((unsigned)u), x2 = bf_lo((unsigned)(u >> 32)), x3 = bf_hi((unsigned)(u >> 32));
        const float rr = 1.f / sqrtf(wave_sum((x0 * x0 + x1 * x1) + (x2 * x2 + x3 * x3)) * (1.f / 256.f) + EPS);
        const f32x4 g = *(const f32x4*)(a.cross_k_norm + l * CHD + 4 * lane);
        *p = (u64)pk2(x0 * rr * g.x, x1 * rr * g.y) | ((u64)pk2(x2 * rr * g.z, x3 * rr * g.w) << 32);
    }
}

__device__ __forceinline__ unsigned f32_key(float f) { const unsigned u = __float_as_uint(f); return (u & 0x80000000u) ? ~u : (u | 0x80000000u); }
__device__ __forceinline__ void d1_block(Frame& F, const bf16* IQ, const bf16* IKW, float* scr, u64* BMb, int b, int q0) {
    const int lane = otid(F.wave) & 63, w = F.wave, r32 = lane & 31, hi = lane >> 5;
    {
        const int head = ((r32 >> 3) << 2) + (r32 & 3), tq = q0 + 2 * w + ((r32 >> 2) & 1);
        const bf16* ap = IQ + (size_t)(head >> 2) * ((size_t)M * 256) + (size_t)(b * T + tq) * 256 + (head & 3) * 64 + 8 * hi;
        bf16x8 afr[4];
#pragma unroll
        for (int ks = 0; ks < 4; ++ks) afr[ks] = *(const bf16x8*)(ap + ks * 16);
        float wq[16];
        { const bf16* wp = IKW + (size_t)(b * T + q0 + 2 * w + hi) * 256;
          const v4u w0 = *(const v4u*)wp, w1 = *(const v4u*)(wp + 8);
          const unsigned ww[8] = {w0.x, w0.y, w0.z, w0.w, w1.x, w1.y, w1.z, w1.w};
#pragma unroll
          for (int j = 0; j < 8; ++j) { wq[2 * j] = bf_lo(ww[j]) * 0.03125f; wq[2 * j + 1] = bf_hi(ww[j]) * 0.03125f; } }
        const int nkt = (q0 + 16 + 31) >> 5;
        const bf16* kp = IKW + (size_t)(b * T + r32) * 256 + 16 + 8 * hi;
        float* sp = scr + (size_t)(2 * w + hi) * T + r32;
        bf16x8 bfr[4];
#pragma unroll
        for (int ks = 0; ks < 4; ++ks) bfr[ks] = *(const bf16x8*)(kp + ks * 16);
        for (int kt = 0; kt < nkt; ++kt) {
            bf16x8 nb[4]; const int ktn = (kt + 1 < nkt) ? kt + 1 : kt;
#pragma unroll
            for (int ks = 0; ks < 4; ++ks) nb[ks] = *(const bf16x8*)(kp + (size_t)ktn * 32 * 256 + ks * 16);
            f32x16 acc = {};
#pragma unroll
            for (int ks = 0; ks < 4; ++ks) acc = __builtin_amdgcn_mfma_f32_32x32x16_bf16(afr[ks], bfr[ks], acc, 0, 0, 0);
            float s = 0.f;
#pragma unroll
            for (int j = 0; j < 16; ++j) s += wq[j] * fmaxf(acc[j], 0.f);
            sp[kt * 32] = s;
#pragma unroll
            for (int ks = 0; ks < 4; ++ks) bfr[ks] = nb[ks];
        }
    }
    __syncthreads();
    for (int qq = 0; qq < 2; ++qq) {
        const int t = q0 + 2 * w + qq;
        const float* rp = scr + (size_t)(2 * w + qq) * T + lane;
        unsigned key[128];
#pragma unroll
        for (int jc = 0; jc < 8; ++jc) {
            if (jc * 1024 <= t) {
#pragma unroll
                for (int jj = 0; jj < 16; ++jj) { const int j = jc * 16 + jj, tj = t - 64 * j; const float v = rp[64 * j]; key[j] = (lane <= tj) ? f32_key(v) : 0u; if ((jj & 3) == 3) __builtin_amdgcn_sched_barrier(0); }
            } else {
#pragma unroll
                for (int jj = 0; jj < 16; ++jj) key[jc * 16 + jj] = 0u;
            }
        }
        unsigned tau = 1u; int need_ties = 0; bool all_ties = true;
        if (t + 1 > TOPK) {
            unsigned prefix = 0u;
            for (int bit = 31; bit >= 0; --bit) {
                const unsigned test = prefix | (1u << bit); int cl = 0;
#pragma unroll
                for (int jc = 0; jc < 8; ++jc) if (jc * 1024 <= t) {
#pragma unroll
                    for (int jj = 0; jj < 16; ++jj) cl += (key[jc * 16 + jj] >= test) ? 1 : 0;
                }
                const int cnt = (int)wave_sum_i(cl);
                if (cnt >= TOPK) prefix = test;
            }
            tau = prefix; int cg = 0, ce = 0;
#pragma unroll
            for (int jc = 0; jc < 8; ++jc) if (jc * 1024 <= t) {
#pragma unroll
                for (int jj = 0; jj < 16; ++jj) { cg += (key[jc * 16 + jj] > tau) ? 1 : 0; ce += (key[jc * 16 + jj] == tau) ? 1 : 0; }
            }
            const int cgt = (int)wave_sum_i(cg), ceq = (int)wave_sum_i(ce);
            need_ties = TOPK - cgt; all_ties = (ceq == need_ties);
        }
        int w0l = 0, w0h = 0, w1l = 0, w1h = 0;
        if (all_ties) {
#define D1W_(J) { const u64 msk = __ballot(key[J] >= tau);   \
              if ((J) < 64) asm volatile("s_nop 4\n\tv_writelane_b32 %0, %2, %4\n\tv_writelane_b32 %1, %3, %4" : "+v"(w0l), "+v"(w0h) : "s"((int)(unsigned)msk), "s"((int)(unsigned)(msk >> 32)), "n"((J) & 63)); \
              else          asm volatile("s_nop 4\n\tv_writelane_b32 %0, %2, %4\n\tv_writelane_b32 %1, %3, %4" : "+v"(w1l), "+v"(w1h) : "s"((int)(unsigned)msk), "s"((int)(unsigned)(msk >> 32)), "n"((J) & 63)); }
#define D1W4_(J) D1W_(J) D1W_((J) + 1) D1W_((J) + 2) D1W_((J) + 3) __builtin_amdgcn_sched_barrier(0);
#define D1W16_(J) D1W4_(J) D1W4_((J) + 4) D1W4_((J) + 8) D1W4_((J) + 12)
#define D1W64_(J) D1W16_(J) D1W16_((J) + 16) D1W16_((J) + 32) D1W16_((J) + 48)
            D1W64_(0) D1W64_(64)
#undef D1W64_
#undef D1W16_
#undef D1W4_
#undef D1W_
        } else {
            int left = need_ties;
            for (int j = 0; j < 128; ++j) {
                const int tj = t - 64 * j; unsigned k = 0u;
                if (tj >= 0) { const float v = rp[64 * j]; k = (lane <= tj) ? f32_key(v) : 0u; }
                u64 msk = __ballot(k > tau), tb = __ballot(k == tau);
                if (tb != 0ull && left > 0) { int c = __builtin_popcountll(tb);
                    while (c > left) { tb &= ~(1ull << (63 - __builtin_clzll(tb))); --c; }
                    msk |= tb; left -= c; }
                const bool me = (lane == (j & 63));
                if (j < 64) { w0l = me ? (int)(unsigned)msk : w0l; w0h = me ? (int)(unsigned)(msk >> 32) : w0h; } else { w1l = me ? (int)(unsigned)msk : w1l; w1h = me ? (int)(unsigned)(msk >> 32) : w1h; }
            }
        }
        const u64 w0 = ((u64)(unsigned)w0h << 32) | (unsigned)w0l, w1 = ((u64)(unsigned)w1h << 32) | (unsigned)w1l;
        BMb[(size_t)lane * T + t] = w0; BMb[(size_t)(64 + lane) * T + t] = w1;
    }
    __syncthreads();
}
__device__ __forceinline__ void d1_phase(Frame& F, unsigned char* ws, float* scratch) {
    const bf16* IQ = (const bf16*)(ws + WS_PROJ + 8 * PROJ_T); const bf16* IKW = (const bf16*)(ws + WS_PROJ + 12 * PROJ_T);
    float* scr = scratch + (size_t)blockIdx.x * 16 * T;
    for (int it = blockIdx.x; it < BATCH * 256; it += F.G) {
        const int b = it >> 8, p = it & 255; u64* BMb = (u64*)(ws + WS_BM) + (size_t)b * 128 * T;
        for (int hh = 0; hh < 2; ++hh) d1_block(F, IQ, IKW, scr, BMb, b, 16 * (hh ? 511 - p : p));
    }
}

namespace xat {
using namespace dsa2;
#define XK(row, colB) ((row) * 512 + ((colB) ^ (((row) & 7) << 4)))
__device__ __forceinline__ void cross_unit(const bf16* CQ, const bf16* MKVl, const float* qgain, bf16* CO, int b, int h, int qb, char* lds, const int wave_) {
    const int tid = otid(wave_);
    const int wid = wave_, lane = tid & 63, r32 = lane & 31, hi = lane >> 5;
    char* V_lds = lds; char* K_lds = lds + 32768;
    float* wsx = (float*)(lds + 65536) + wid * 64; float* li_l = wsx, * al_l = wsx + 32;
    const size_t row = (size_t)b * ::T + qb * 256 + wid * 32 + r32;
    bf16x8 qr[16]; float ss = 0.f;
    const bf16* qp = CQ + row * ::D + h * CHD + 8 * hi;
#pragma unroll
    for (int d0 = 0; d0 < 16; ++d0) { qr[d0] = *(const bf16x8*)(qp + d0 * 16);
#pragma unroll
        for (int j = 0; j < 8; ++j) { const float x = __uint_as_float(((unsigned)(unsigned short)qr[d0][j]) << 16); ss += x * x; } }
    ss += __shfl_xor(ss, 32);
    const float rn = 1.f / sqrtf(ss * (1.f / 256.f) + EPS);
#pragma unroll
    for (int d0 = 0; d0 < 16; ++d0) { const f32x4 g0 = *(const f32x4*)(qgain + d0 * 16 + 8 * hi), g1 = *(const f32x4*)(qgain + d0 * 16 + 8 * hi + 4);
        f32x4 a, c;
#pragma unroll
        for (int j = 0; j < 4; ++j) { a[j] = __uint_as_float(((unsigned)(unsigned short)qr[d0][j]) << 16) * rn * g0[j]; c[j] = __uint_as_float(((unsigned)(unsigned short)qr[d0][4 + j]) << 16) * rn * g1[j]; }
        qr[d0] = pack8(a, c); asm volatile("" ::: "memory"); }
    const int vb0 = (int)(uintptr_t)V_lds + v_rd_base(lane);
    const int sr = tid >> 4, sc = (tid & 15) * 8;
    const bf16* Kg = MKVl + (size_t)(b * MEML) * 2048 + h * CHD; const bf16* Vg = Kg + 1024;
    constexpr float XSCALE = 0.0625f;
    for (int pass = 0; pass < 2; ++pass) {
        float m_reg = -1e30f, l_reg = 0.f; f32x16 o[4] = {};
        for (int t = 0; t < 4; ++t) {
            __syncthreads();
#pragma unroll
            for (int i = 0; i < 4; ++i) { const int ch = tid + 512 * i, kr = ch >> 5, cc = ch & 31;
                *(bf16x8*)(K_lds + XK(kr, cc * 16)) = *(const bf16x8*)(Kg + (size_t)(t * 64 + kr) * 2048 + cc * 8); }
            *(bf16x8*)(V_lds + v_st(sr, sc)) = *(const bf16x8*)(Vg + (size_t)(t * 64 + sr) * 2048 + pass * 128 + sc);
            *(bf16x8*)(V_lds + v_st(32 + sr, sc)) = *(const bf16x8*)(Vg + (size_t)(t * 64 + 32 + sr) * 2048 + pass * 128 + sc);
            __syncthreads();
            f32x16 p0 = {}, p1 = {};
            const char* kb[4];
#pragma unroll
            for (int dd = 0; dd < 4; ++dd) kb[dd] = K_lds + XK(r32, dd * 32 + hi * 16);
#pragma unroll
            for (int d0 = 0; d0 < 16; ++d0) { const char* ka = kb[d0 & 3] + (d0 >> 2) * 128;
                const bf16x8 k0 = *(const bf16x8*)ka;
                const bf16x8 k1 = *(const bf16x8*)(ka + 32 * 512);
                p0 = __builtin_amdgcn_mfma_f32_32x32x16_bf16(k0, qr[d0], p0, 0, 0, 0);
                p1 = __builtin_amdgcn_mfma_f32_32x32x16_bf16(k1, qr[d0], p1, 0, 0, 0); }
            float mn, alpha; bf16x8 pa0, pa1, pa2, pa3;
            partialSM_s(p0, p1, m_reg, mn, alpha, XSCALE);
            finishSM(p0, p1, alpha, l_reg, pa0, pa1, pa2, pa3);
            if (__any(alpha < 1.f)) { if (hi == 0) al_l[r32] = alpha; asm volatile("s_waitcnt lgkmcnt(0)" ::: "memory");
#pragma unroll
                for (int d_ = 0; d_ < 4; ++d_)
#pragma unroll
                    for (int r = 0; r < 16; ++r) o[d_][r] *= al_l[crow(r, hi)]; }
            pv_tile<0, false>(o, vb0, pa0, pa1, pa2, pa3, true);
        }
        if (hi == 0) li_l[r32] = l_reg; asm volatile("s_waitcnt lgkmcnt(0)" ::: "memory");
        bf16* Ow = CO + ((size_t)b * ::T + qb * 256 + wid * 32) * ::D + h * CHD + pass * 128;
#pragma unroll
        for (int r = 0; r < 16; ++r) { const int orow = crow(r, hi); const float rl = __builtin_amdgcn_rcpf(li_l[orow]);
#pragma unroll
            for (int d0 = 0; d0 < 4; ++d0) { const float v = o[d0][r] * rl; const float vn = __shfl_xor(v, 1);
                if ((r32 & 1) == 0) *(unsigned*)(Ow + (size_t)orow * ::D + d0 * 32 + r32) = cvtpk(v, vn); } }
    }
    __syncthreads();
}
#undef XK
__device__ __forceinline__ void cross_phase(Frame& F, char* lds, const bf16* CQ, const bf16* MKVl, const float* qgain, bf16* CO) {
    for (int u = blockIdx.x; u < BATCH * 4 * (::T / 256); u += F.G) {
        const int qb = u & 31, h = (u >> 5) & 3, b = u >> 7;
        cross_unit(CQ, MKVl, qgain, CO, b, h, qb, lds, F.wave);
    }
}
}

namespace dsa2 {
typedef unsigned short TI;
__device__ __forceinline__ BlockRef<TI, TI> d2_ref(unsigned char* ws, int bh, int qb) {
    const int b = bh >> 2, h = bh & 3; BlockRef<TI, TI> r;
    const size_t rowq = (size_t)b * ::T + (size_t)qb * QB, rowk = (size_t)b * ::T;
    r.Q = (const TI*)(ws + WS_PROJ + (size_t)(0 + (h >> 1)) * PROJ_T) + rowq * LDQ + (h & 1) * 128;
    r.K = (const TI*)(ws + WS_PROJ + (size_t)(2 + (h >> 1)) * PROJ_T) + rowk * LDQ + (h & 1) * 128;
    r.V = (const TI*)(ws + WS_PROJ + (size_t)(4 + (h >> 1)) * PROJ_T) + rowk * LDQ + (h & 1) * 128;
    r.O = (TI*)(ws + WS_XN) + rowq * LDO + h * 128;
    r.MW = (const unsigned long long*)(ws + WS_BM) + (size_t)b * 128 * ::T;
    r.P0 = qb * QB; return r;
}
__device__ __forceinline__ void d2_phase(char* lds, unsigned char* ws, int G, const int wave_) {
    constexpr int nqb = ::T / QB, nx = nqb / 2, total = nx * BATCH * 4;
    int L = blockIdx.x; if (L >= total) return;
    int bh = L / nx, x = L % nx, pass = 0;
    BlockRef<TI, TI> cur = d2_ref(ws, bh, x);
    Seam<TI> S;
    causal_swa_prime<TI, TI>(cur, ::T, lds, S, wave_);
    for (;;) {
        const bool more_pass = pass == 0, more_item = L + G < total, last = !more_pass && !more_item;
        int Ln = L, passn = pass + 1, bhn = bh, xn = x;
        if (!more_pass) { passn = 0; Ln = more_item ? L + G : L; bhn = Ln / nx; xn = Ln % nx; }
        const BlockRef<TI, TI> nxt = last ? cur : d2_ref(ws, bhn, passn ? nqb - 1 - xn : xn);
        causal_swa_block<TI, TI>(cur, nxt, ::T, ::T, lds, S, wave_);
        if (last) break;
        cur = nxt; L = Ln; pass = passn; bh = bhn; x = xn;
    }
}
}

__device__ __forceinline__ void conv_phase(Frame& F, char* lds, const bf16* Gin, const float* dw_w, const float* dw_b, const float* ln_g, const float* ln_b, bf16* OUT) {
    const int tid = otid(F.wave);
    const int lane = tid & 63, wave = F.wave;
    float w0[CW], w1[CW];
#pragma unroll
    for (int j = 0; j < CW; ++j) { const float2 v = *(const float2*)(dw_w + j * D + 2 * tid); w0[j] = v.x; w1[j] = v.y; asm volatile("" : "+v"(w0[j]), "+v"(w1[j])); }
    const float2 bias = *(const float2*)(dw_b + 2 * tid), lg = *(const float2*)(ln_g + 2 * tid), lb = *(const float2*)(ln_b + 2 * tid);
    float* red = (float*)lds; float* stat = red + 512;
    const GAS unsigned* G32 = (const GAS unsigned*)Gin; GAS unsigned* O32 = (GAS unsigned*)OUT;
    for (int tile = blockIdx.x; tile < M / 32; tile += F.G) {
        const int row0 = tile * 32, t0 = row0 & (T - 1);
        float a0[32], a1[32];
#pragma unroll
        for (int r = 0; r < 32; ++r) { a0[r] = bias.x; a1[r] = bias.y; }
        const GAS unsigned* gp = G32 + ((ptrdiff_t)row0 - (CW - 1)) * 512 + tid;
#pragma unroll
        for (int i = -(CW - 1); i < 32; ++i) {
            asm volatile("" : "+v"(gp));
            const bool ok = (t0 + i >= 0);
            const GAS unsigned* gcur = ok ? gp : (G32 + tid); gp += 512;
            unsigned u = *gcur; u = ok ? u : 0u; const float x0 = bf_lo(u), x1 = bf_hi(u);
#pragma unroll
            for (int r = (i < 0 ? 0 : i); r <= (i + CW - 1 > 31 ? 31 : i + CW - 1); ++r) { a0[r] += w0[i + CW - 1 - r] * x0; a1[r] += w1[i + CW - 1 - r] * x1; }
        }
#pragma unroll
        for (int r = 0; r < 32; ++r) { const float s = wave_sum(a0[r] + a1[r]), q = wave_sum(a0[r] * a0[r] + a1[r] * a1[r]); if (lane == 0) { red[(r * 8 + wave) * 2] = s; red[(r * 8 + wave) * 2 + 1] = q; } }
        __syncthreads();
        if (tid < 32) { float s = 0.f, q = 0.f;
#pragma unroll
            for (int k = 0; k < 8; ++k) { s += red[(tid * 8 + k) * 2]; q += red[(tid * 8 + k) * 2 + 1]; }
            const float mean = s * (1.f / D), var = fmaxf(q * (1.f / D) - mean * mean, 0.f);
            stat[2 * tid] = mean; stat[2 * tid + 1] = 1.f / sqrtf(var + EPS); }
        __syncthreads();
#pragma unroll
        for (int r = 0; r < 32; ++r) { const float mean = stat[2 * r], rstd = stat[2 * r + 1];
            float y0 = (a0[r] - mean) * rstd * lg.x + lb.x, y1 = (a1[r] - mean) * rstd * lg.y + lb.y;
            y0 = y0 * __builtin_amdgcn_rcpf(1.f + __builtin_amdgcn_exp2f(-1.4426950408889634f * y0)); y1 = y1 * __builtin_amdgcn_rcpf(1.f + __builtin_amdgcn_exp2f(-1.4426950408889634f * y1));
            O32[(size_t)(row0 + r) * 512 + tid] = pk2(y0, y1); }
        __syncthreads();
    }
}

constexpr int NPHASE = 28;
struct Args { const float* in[28]; float* out; unsigned char* ws; int ph_lo, ph_hi; };
template <int LO, int HI> __global__ void __launch_bounds__(NWAVES * 64, 2) trunk_fwd(Args args) {
    extern __shared__ __attribute__((aligned(16))) unsigned char lds[];
    Frame F;
    F.lds = (LAS unsigned char*)lds;
    F.MISC = (volatile LAS unsigned*)(F.lds + MISC_OFF);
    F.wave = __builtin_amdgcn_readfirstlane(threadIdx.x >> 6); F.tid = 0; F.lane = 0;
    F.G = gridDim.x;
    unsigned char* ws = args.ws;
    F.ctl = (gu32*)(ws + WS_CTL);
    for (int u = otid(F.wave); u < (LDS_BYTES - LDSCTL_OFF) / 4; u += NWAVES * 64) ((LAS unsigned*)(F.lds + LDSCTL_OFF))[u] = 0u;
    __syncthreads();
    XcdBarrier bar; bar.wave = F.wave; bar.bar = (unsigned*)(F.ctl + CW_BAR); bar.x = 0; bar.st = nullptr;
    if (!MK_PER_PHASE) bar = xcd_barrier_post((unsigned*)(F.ctl + CW_BAR), F.MISC + 8, F.wave);
    constexpr int lo = LO, hi = HI;
#ifdef ONLY_PHASE
#define IN(k) (((k) == ONLY_PHASE || ((k) >= 17 && (k) - 11 == ONLY_PHASE)) && lo <= (k) && (k) < hi)
#else
#define IN(k) (lo <= (k) && (k) < hi)
#endif
#define SEAM(k) do { if (!MK_PER_PHASE && (k) + 1 < hi) xcd_barrier(bar); } while (0)
    const float* const volatile __attribute__((address_space(4)))* kin = (const float* const volatile __attribute__((address_space(4)))*)__builtin_amdgcn_kernarg_segment_ptr();
#define INP(i) (kin[i])
    float* H = args.out;
    bf16* XN = (bf16*)(ws + WS_XN);

    if (IN(0)) {
        P0Args a{INP(0), INP(1), INP(2), INP(4), INP(6), INP(9), INP(10), INP(11), INP(12), INP(18), INP(19), INP(20), INP(21), INP(24), INP(25), INP(26), INP(27), ws};
        p0_prologue(F, a); SEAM(0);
    }
    if (IN(1)) {
        { pg8::Gemm g{XN, (const bf16*)(ws + WS_WIN), M, NINP, D}; pg8::StaticOrder S; S.init(M, NINP, F.G, (int)blockIdx.x);
          pg8::EpiBf16<0> E{(bf16*)(ws + WS_PROJ), 256, nullptr, 256, (size_t)M * 256, 1.f};
          pg8::gemm_phase<pg8::EpiBf16<0>, pg8::StaticOrder, true, true>(F.lds + RING_OFF, g, S, E, F.wave); }
        for (int l = 0; l < 2; ++l) {
          pg8::Gemm g{(const bf16*)(ws + WS_MEMN) + (size_t)l * MROWS * D, (const bf16*)(ws + WS_WCKV) + (size_t)l * 2 * D * D, MROWS, 2 * D, D}; pg8::StaticOrder S; S.init(MROWS, 2 * D, F.G, (int)((blockIdx.x + 128 - 32 * l) % F.G));
          pg8::EpiBf16<0> E{(bf16*)(ws + WS_MKV) + (size_t)l * MROWS * 2 * D, 2 * D, nullptr, 0, 0, 1.f};
          pg8::gemm_phase<pg8::EpiBf16<0>, pg8::StaticOrder, true, true>(F.lds + RING_OFF, g, S, E, F.wave); }
        SEAM(1);
    }
    if (IN(2)) { P2Args a{INP(7), INP(8), INP(23), ws}; p2_post(F, a); SEAM(2); }
    if (IN(3)) { if (!(DBG_SKIP & 1)) d1_phase(F, ws, H); SEAM(3); }
    if (IN(4)) { if (!(DBG_SKIP & 1)) dsa2::d2_phase((char*)lds + RING_OFF, ws, F.G, F.wave);
                 else { const int t_ = otid(F.wave); for (size_t i = (size_t)blockIdx.x * 512 + t_; i < (size_t)M * 256; i += (size_t)F.G * 512) ((unsigned*)(ws + WS_XN))[(i >> 8) * 512 + (i & 255)] = 0u; }
                 SEAM(4); }
    if (IN(5)) {
        pg8::Gemm g{XN, (const bf16*)(ws + WS_WOUT), M, D, D}; pg8::StaticOrder S; S.init(M, D, F.G, (int)blockIdx.x);
        pg8::EpiRes E{INP(0), H, D};
        pg8::gemm_phase<pg8::EpiRes, pg8::StaticOrder, true, true>(F.lds + RING_OFF, g, S, E, F.wave); SEAM(5);
    }
#if MK_PER_PHASE
#pragma unroll
#else
#pragma unroll 1
#endif
    for (int l = 0; l < 2; ++l) {
        const int pb = 6 + 11 * l;
        if (l == 1) {
            if (IN(pb + 0)) { norm_phase(F, H, INP(2) + D, XN); SEAM(pb + 0); }
            if (IN(pb + 1)) {
                pg8::Gemm g{XN, (const bf16*)(ws + WS_WCIN), M, 2 * D, D}; pg8::StaticOrder S; S.init(M, 2 * D, F.G, (int)blockIdx.x);
                pg8::EpiGate<1> E{(bf16*)(ws + WS_G), D, INP(13), D};
                pg8::gemm_phase<pg8::EpiGate<1>, pg8::StaticOrder, true, true>(F.lds + RING_OFF, g, S, E, F.wave); SEAM(pb + 1);
            }
            if (IN(pb + 2)) { conv_phase(F, (char*)lds + RING_OFF, (const bf16*)(ws + WS_G), INP(14), INP(15), INP(16), INP(17), XN); SEAM(pb + 2); }
            if (IN(pb + 3)) {
                pg8::Gemm g{XN, (const bf16*)(ws + WS_WCOUT), M, D, D}; pg8::StaticOrder S; S.init(M, D, F.G, (int)blockIdx.x);
                pg8::EpiRes E{H, H, D};
                pg8::gemm_phase<pg8::EpiRes, pg8::StaticOrder, true, true>(F.lds + RING_OFF, g, S, E, F.wave); SEAM(pb + 3);
            }
        }
        if (IN(pb + 4)) { norm_phase(F, H, INP(3) + l * D, XN); SEAM(pb + 4); }
        if (IN(pb + 5)) {
            pg8::Gemm g{XN, (const bf16*)(ws + WS_WCQ) + (size_t)l * D * D, M, D, D}; pg8::StaticOrder S; S.init(M, D, F.G, (int)blockIdx.x);
            pg8::EpiBf16<0> E{(bf16*)(ws + WS_CQ), D, nullptr, 0, 0, 1.f};
            pg8::gemm_phase<pg8::EpiBf16<0>, pg8::StaticOrder, true, true>(F.lds + RING_OFF, g, S, E, F.wave); SEAM(pb + 5);
        }
        if (IN(pb + 6)) { xat::cross_phase(F, (char*)lds + RING_OFF, (const bf16*)(ws + WS_CQ), (const bf16*)(ws + WS_MKV) + (size_t)l * MROWS * 2 * D, INP(22) + l * CHD, (bf16*)(ws + WS_CO)); SEAM(pb + 6); }
        if (IN(pb + 7)) {
            pg8::Gemm g{(const bf16*)(ws + WS_CO), (const bf16*)(ws + WS_WCO) + (size_t)l * D * D, M, D, D}; pg8::StaticOrder S; S.init(M, D, F.G, (int)blockIdx.x);
            pg8::EpiRes E{H, H, D};
            pg8::gemm_phase<pg8::EpiRes, pg8::StaticOrder, true, true>(F.lds + RING_OFF, g, S, E, F.wave); SEAM(pb + 7);
        }
        if (IN(pb + 8)) { norm_phase(F, H, INP(5) + l * D, XN); SEAM(pb + 8); }
        if (IN(pb + 9)) {
            pg8::Gemm g{XN, (const bf16*)(ws + WS_WGU) + (size_t)l * 2 * DFF * D, M, 2 * DFF, D}; pg8::StaticOrder S; S.init(M, 2 * DFF, F.G, (int)blockIdx.x);
            pg8::EpiGate<0> E{(bf16*)(ws + WS_HID), DFF, nullptr, 0};
            pg8::gemm_phase<pg8::EpiGate<0>, pg8::StaticOrder, true, true>(F.lds + RING_OFF, g, S, E, F.wave); SEAM(pb + 9);
        }
        if (IN(pb + 10)) {
            pg8::Gemm g{(const bf16*)(ws + WS_HID), (const bf16*)(ws + WS_WDN) + (size_t)l * D * DFF, M, D, DFF}; pg8::StaticOrder S; S.init(M, D, F.G, (int)blockIdx.x);
            pg8::EpiRes E{H, H, D};
            pg8::gemm_phase<pg8::EpiRes, pg8::StaticOrder, true, true>(F.lds + RING_OFF, g, S, E, F.wave); SEAM(pb + 10);
        }
    }
#undef IN
#undef SEAM
}

extern "C" void kernel_launch(void* const* d_in, const int* in_sizes, int n_in, void* d_out, int out_size, void* d_ws, size_t ws_size, hipStream_t stream) {
    static int grid = 0;
    if (grid == 0) {
        if (n_in != 28 || in_sizes[0] != M * D || out_size != M * D || ws_size < WS_END) { fprintf(stderr, "kernel_launch: unexpected shapes (n_in %d, in0 %d, out %d, ws %zu)\n", n_in, n_in > 0 ? in_sizes[0] : -1, out_size, ws_size); grid = -1; return; }
        int dev = 0, cus = 0, per_cu = 0;
        if (hipGetDevice(&dev) != hipSuccess || hipDeviceGetAttribute(&cus, hipDeviceAttributeMultiprocessorCount, dev) != hipSuccess) { grid = -1; return; }
#if !MK_PER_PHASE
        if (hipFuncSetAttribute((const void*)trunk_fwd<0, NPHASE>, hipFuncAttributeMaxDynamicSharedMemorySize, LDS_BYTES) != hipSuccess) { fprintf(stderr, "kernel_launch: hipFuncSetAttribute failed\n"); grid = -1; return; }
        if (hipOccupancyMaxActiveBlocksPerMultiprocessor(&per_cu, (const void*)trunk_fwd<0, NPHASE>, NWAVES * 64, LDS_BYTES) != hipSuccess || per_cu < 1) fprintf(stderr, "kernel_launch: note: occupancy query reports %d workgroups per CU\n", per_cu);
#endif
        (void)hipGetLastError();
        grid = cus > 256 ? 256 : cus;
    }
    if (grid < 0) return;
    if (hipMemsetAsync((char*)d_ws + WS_CTL, 0, CTL_ZERO_BYTES, stream) != hipSuccess) return;
    Args a{};
    for (int i = 0; i < 28; ++i) a.in[i] = (const float*)d_in[i];
    a.out = (float*)d_out; a.ws = (unsigned char*)d_ws;
#if MK_PER_PHASE
#define LAUNCH_PH(p) do { static bool attr_ = false; if (!attr_) { (void)hipFuncSetAttribute((const void*)trunk_fwd<p, p + 1>, hipFuncAttributeMaxDynamicSharedMemorySize, LDS_BYTES); attr_ = true; } \
        hipLaunchKernelGGL((trunk_fwd<p, p + 1>), dim3(grid), dim3(NWAVES * 64), LDS_BYTES, stream, a); } while (0)
    LAUNCH_PH(0); LAUNCH_PH(1); LAUNCH_PH(2); LAUNCH_PH(3); LAUNCH_PH(4); LAUNCH_PH(5);
    LAUNCH_PH(10); LAUNCH_PH(11); LAUNCH_PH(12); LAUNCH_PH(13); LAUNCH_PH(14); LAUNCH_PH(15); LAUNCH_PH(16);
    LAUNCH_PH(17); LAUNCH_PH(18); LAUNCH_PH(19); LAUNCH_PH(20); LAUNCH_PH(21); LAUNCH_PH(22); LAUNCH_PH(23); LAUNCH_PH(24); LAUNCH_PH(25); LAUNCH_PH(26); LAUNCH_PH(27);
#else
    hipLaunchKernelGGL((trunk_fwd<0, NPHASE>), dim3(grid), dim3(NWAVES * 64), LDS_BYTES, stream, a);
#endif
}
```

```cpp
#include <hip/hip_runtime.h>
#include <cstdio>
#include <cstdint>
__device__ __forceinline__ int obid() { int b = blockIdx.x; asm volatile("" : "+s"(b)); return b; }
__device__ __forceinline__ int lane_id_() { int l; asm volatile("v_mbcnt_lo_u32_b32 %0, -1, 0\n\tv_mbcnt_hi_u32_b32 %0, -1, %0" : "=v"(l)); return l; }
__device__ __forceinline__ int otid(int wave) { return wave * 64 + lane_id_(); }
namespace pg8 {
#define PG8_LAS __attribute__((address_space(3)))
typedef unsigned short bf16_t;
typedef short bf16x8 __attribute__((ext_vector_type(8)));
typedef float f32x4 __attribute__((ext_vector_type(4)));
typedef unsigned u32x4 __attribute__((ext_vector_type(4)));
constexpr int BM = 256, BK = 64, HALF = 128, HTB = HALF * BK * 2  , STAGE_BYTES = 8 * HTB, NXCD = 8, WGM = 4;

__host__ __device__ __forceinline__ int lds_byte(int r, int c) { const int st = (r >> 4) * 2 + (c >> 5), rr = r & 15, cc = c & 31, ob = rr * 64 + cc * 2; return st * 1024 + (ob ^ (((ob >> 9) & 1) << 5)); }
__host__ __device__ __forceinline__ void stage_rc(int b, int& R, int& C) { const int st = b / 1024, sb = b % 1024, swz = sb ^ (((sb >> 9) & 1) << 5); R = (st >> 1) * 16 + swz / 64; C = (st & 1) * 32 + (swz % 64) / 2; }
__host__ __device__ __forceinline__ int perm32(int rho) { const int n = rho >> 4, i = rho & 15; return 8 * (i >> 2) + 4 * n + (i & 3); }

struct Unit { int pm, pn, idx; };
struct Gemm { const bf16_t* A; const bf16_t* Bt; int M, N, K; };

struct StaticOrder {
    int nM, nN, nwg, G, c, rev;
    __host__ __device__ __attribute__((always_inline)) void init(int M, int N, int G_, int c_, int rev_ = 0) { nM = M / BM; nN = N / BM; nwg = nM * nN; G = G_; c = c_; rev = (rev_ && nwg % G_ == 0) ? nwg / G_ : 0; }
    __host__ __device__ bool next(int i, Unit& u) const {
        const long L = (long)(rev ? (i < rev ? rev - 1 - i : i) : i) * G + c; if (L >= nwg) return false;
        int wgid = (int)L; { const int q = nwg / NXCD, r = nwg % NXCD, xcd = wgid % NXCD, off = wgid / NXCD; wgid = (xcd < r ? xcd * (q + 1) : r * (q + 1) + (xcd - r) * q) + off; }
        const int nig = WGM * nN, gid = wgid / nig, fm = gid * WGM, gsz = (nM - fm) < WGM ? (nM - fm) : WGM;
        u.pm = fm + ((wgid % nig) % gsz); u.pn = (wgid % nig) / gsz; u.idx = i; return true;
    }
    __device__ __forceinline__ void a_ready(const Unit&) const {}
    __device__ __forceinline__ void done(const Unit&) const {}
};

__device__ __forceinline__ unsigned cvt_pk_bf16(float lo, float hi) { unsigned r; asm volatile("v_cvt_pk_bf16_f32 %0, %1, %2" : "=v"(r) : "v"(lo), "v"(hi)); return r; }
typedef float f32x2 __attribute__((ext_vector_type(2)));
__device__ __forceinline__ f32x2 gelu_pk(f32x2 v) {
    const f32x2 av = __builtin_elementwise_abs(v), d = av * 0.2316418882f + 1.0f;
    f32x2 t; t.x = __builtin_amdgcn_rcpf(d.x); t.y = __builtin_amdgcn_rcpf(d.y);
    f32x2 q = t * 0.5307027145f + (-0.7265760135f); q = q * t + 0.7107068705f; q = q * t + (-0.142248368f); q = q * t + 0.127414796f; q = q * t;
    const f32x2 s = (v * v) * (-0.72134752044f);
    f32x2 e; e.x = __builtin_amdgcn_exp2f(s.x); e.y = __builtin_amdgcn_exp2f(s.y);
    const f32x2 m = v * (q * e), r = v - m;
    f32x2 o; o.x = v.x < 0.f ? m.x : r.x; o.y = v.y < 0.f ? m.y : r.y; return o;
}

__device__ __forceinline__ float row_rstd(const float* ssq, int row);
__device__ __forceinline__ void store16_wt(void* p, u32x4 v) { asm volatile("global_store_dwordx4 %0, %1, off sc1\n\ts_nop 2" :: "v"(p), "v"(v) : "memory"); }
template <int ACT  , bool RS = false  , bool WT = false> struct EpiBf16 {
    static constexpr bool PERM = true, AFTER_DRAIN = false; static_assert(ACT == 0 || ACT == 1, "EpiBf16: ACT is 0 (none) or 1 (gelu_pk)");
    bf16_t* O; int ldc; const float* bias; int split_cols; size_t split_stride; float scale0; const float* ssq;
    __device__ __forceinline__ void operator()(const f32x4 (&acc)[2][2][4][2], const Unit& u, int wr, int wc, int fr, int fq) const {
        const int row0 = u.pm * BM + wr * 64 + fr; int colt = u.pn * BM; bf16_t* base = O;
        float sc = 1.f; if (split_cols) { const int t = colt / split_cols; base += (size_t)t * split_stride; colt -= t * split_cols; if (t == 0) sc = scale0; }
        const int col0 = colt + wc * 32 + 8 * fq, bcol0 = u.pn * BM + wc * 32 + 8 * fq;
        f32x4 bv[2][2];
#pragma unroll
        for (int bj = 0; bj < 2; ++bj)
#pragma unroll
            for (int n = 0; n < 2; ++n) bv[bj][n] = bias ? *(const f32x4*)(bias + bcol0 + bj * HALF + 4 * n) : (f32x4){0.f, 0.f, 0.f, 0.f};
#pragma unroll
        for (int ai = 0; ai < 2; ++ai)
#pragma unroll
            for (int m = 0; m < 4; ++m) { bf16_t* rowp = base + (size_t)(row0 + ai * HALF + m * 16) * ldc + col0;
                const float rs = RS ? row_rstd(ssq, row0 + ai * HALF + m * 16) : 1.0f;
#pragma unroll
                for (int bj = 0; bj < 2; ++bj) { f32x4 v0 = acc[ai][bj][m][0] * rs + bv[bj][0], v1 = acc[ai][bj][m][1] * rs + bv[bj][1];
                    if (ACT == 1) { f32x2 a = gelu_pk((f32x2){v0[0], v0[1]}), b = gelu_pk((f32x2){v0[2], v0[3]}), c = gelu_pk((f32x2){v1[0], v1[1]}), d = gelu_pk((f32x2){v1[2], v1[3]});
                        v0 = (f32x4){a.x, a.y, b.x, b.y}; v1 = (f32x4){c.x, c.y, d.x, d.y}; }
                    v0 = v0 * sc; v1 = v1 * sc; u32x4 w; w.x = cvt_pk_bf16(v0[0], v0[1]); w.y = cvt_pk_bf16(v0[2], v0[3]); w.z = cvt_pk_bf16(v1[0], v1[1]); w.w = cvt_pk_bf16(v1[2], v1[3]);
                    if (WT) store16_wt(rowp + bj * HALF, w); else *(u32x4*)(rowp + bj * HALF) = w; } }
    }
};

template <bool BASE_F32> struct EpiRes2 {
    static constexpr bool PERM = true, AFTER_DRAIN = false;
    const void* base; float* C; bf16_t* HB; float* ssq; int ldc;
    __device__ __forceinline__ void emit(const f32x4 (&acc)[2][2][4][2], const f32x4 (&bs)[2][2], const Unit& u, int ai, int m, int row, size_t off, int wc, int fq) const {
        float ss = 0.f;
#pragma unroll
        for (int bj = 0; bj < 2; ++bj) { const f32x4 v0 = bs[bj][0] + acc[ai][bj][m][0], v1 = bs[bj][1] + acc[ai][bj][m][1];
            if (C) { *(f32x4*)(C + off + bj * HALF) = v0; *(f32x4*)(C + off + bj * HALF + 4) = v1; }
            else { ss += ((v0[0] * v0[0] + v0[1] * v0[1]) + (v0[2] * v0[2] + v0[3] * v0[3])) + ((v1[0] * v1[0] + v1[1] * v1[1]) + (v1[2] * v1[2] + v1[3] * v1[3]));
                u32x4 w; w.x = cvt_pk_bf16(v0[0], v0[1]); w.y = cvt_pk_bf16(v0[2], v0[3]); w.z = cvt_pk_bf16(v1[0], v1[1]); w.w = cvt_pk_bf16(v1[2], v1[3]);
                *(u32x4*)(HB + off + bj * HALF) = w; } }
        if (!C) { ss += __shfl_xor(ss, 16); ss += __shfl_xor(ss, 32);
            if (fq == 0) ssq[(size_t)row * 16 + u.pn * 4 + wc] = ss; }
    }
    __device__ __forceinline__ void operator()(const f32x4 (&acc)[2][2][4][2], const Unit& u, int wr, int wc, int fr, int fq) const {
        const int row0 = u.pm * BM + wr * 64 + fr, col0 = u.pn * BM + wc * 32 + 8 * fq;
        if constexpr (!BASE_F32) {
            u32x4 bw[8][2];
#pragma unroll
            for (int it = 0; it < 8; ++it) { const bf16_t* p = (const bf16_t*)base + (size_t)(row0 + (it >> 2) * HALF + (it & 3) * 16) * ldc + col0;
                bw[it][0] = *(const u32x4*)p; bw[it][1] = *(const u32x4*)(p + HALF); }
#pragma unroll
            for (int it = 0; it < 8; ++it) { const int ai = it >> 2, m = it & 3, row = row0 + ai * HALF + m * 16; const size_t off = (size_t)row * ldc + col0;
                f32x4 bs[2][2];
#pragma unroll
                for (int bj = 0; bj < 2; ++bj) { const u32x4 w = bw[it][bj];
                    bs[bj][0] = (f32x4){__uint_as_float(w.x << 16), __uint_as_float(w.x & 0xffff0000u), __uint_as_float(w.y << 16), __uint_as_float(w.y & 0xffff0000u)};
                    bs[bj][1] = (f32x4){__uint_as_float(w.z << 16), __uint_as_float(w.z & 0xffff0000u), __uint_as_float(w.w << 16), __uint_as_float(w.w & 0xffff0000u)}; }
                emit(acc, bs, u, ai, m, row, off, wc, fq); }
        } else {
            f32x4 bq[4][2][2];
#pragma unroll
            for (int it = 0; it < 4; ++it) { const float* p = (const float*)base + (size_t)(row0 + it * 16) * ldc + col0;
#pragma unroll
                for (int bj = 0; bj < 2; ++bj) { bq[it][bj][0] = *(const f32x4*)(p + bj * HALF); bq[it][bj][1] = *(const f32x4*)(p + bj * HALF + 4); } }
#pragma unroll
            for (int it = 0; it < 8; ++it) { const int ai = it >> 2, m = it & 3, row = row0 + ai * HALF + m * 16; const size_t off = (size_t)row * ldc + col0;
                emit(acc, bq[it & 3], u, ai, m, row, off, wc, fq);
                if (it < 4) { const float* p = (const float*)base + off + (size_t)HALF * ldc;
#pragma unroll
                    for (int bj = 0; bj < 2; ++bj) { bq[it][bj][0] = *(const f32x4*)(p + bj * HALF); bq[it][bj][1] = *(const f32x4*)(p + bj * HALF + 4); } } }
        }
    }
};
__device__ __forceinline__ float row_rstd(const float* ssq, int row) {
    const f32x4* p = (const f32x4*)(ssq + (size_t)row * 16); const f32x4 a = p[0], b = p[1], c = p[2], d = p[3];
    const float s = ((a[0] + a[1]) + (a[2] + a[3])) + ((b[0] + b[1]) + (b[2] + b[3])) + ((c[0] + c[1]) + (c[2] + c[3])) + ((d[0] + d[1]) + (d[2] + d[3]));
    return 1.0f / sqrtf(s * (1.0f / 1024.0f) + 1e-6f);
}
template <int MODE> struct EpiGate {
    static constexpr bool PERM = true, AFTER_DRAIN = false;
    bf16_t* O; int ldc; const float* bias; int NH; const PG8_LAS float* rstd;
    __device__ __forceinline__ void operator()(const f32x4 (&acc)[2][2][4][2], const Unit& u, int wr, int wc, int fr, int fq) const {
        const int row0 = u.pm * BM + wr * 64 + fr, col0 = u.pn * HALF + wc * 32 + 8 * fq;
        f32x4 bl[2], br[2];
#pragma unroll
        for (int n = 0; n < 2; ++n) { bl[n] = (MODE == 1) ? *(const f32x4*)(bias + col0 + 4 * n) : (f32x4){0.f, 0.f, 0.f, 0.f}; br[n] = (MODE == 1) ? *(const f32x4*)(bias + NH + col0 + 4 * n) : (f32x4){0.f, 0.f, 0.f, 0.f}; }
#pragma unroll
        for (int ai = 0; ai < 2; ++ai)
#pragma unroll
            for (int m = 0; m < 4; ++m) { bf16_t* rowp = O + (size_t)(row0 + ai * HALF + m * 16) * ldc + col0;
                const float rs = rstd[u.idx * BM + wr * 64 + fr + ai * HALF + m * 16];
                f32x4 v[2];
#pragma unroll
                for (int n = 0; n < 2; ++n) { const f32x4 l = acc[ai][0][m][n] * rs + bl[n], r = acc[ai][1][m][n] * rs + br[n];
#pragma unroll
                    for (int j = 0; j < 4; ++j) {
                        if (MODE == 0) { const float s = __builtin_amdgcn_rcpf(1.0f + __builtin_amdgcn_exp2f(-1.4426950408889634f * l[j])); v[n][j] = l[j] * s * r[j]; }
                        else { const float s = __builtin_amdgcn_rcpf(1.0f + __builtin_amdgcn_exp2f(-1.4426950408889634f * r[j])); v[n][j] = l[j] * s; } } }
                u32x4 w; w.x = cvt_pk_bf16(v[0][0], v[0][1]); w.y = cvt_pk_bf16(v[0][2], v[0][3]); w.z = cvt_pk_bf16(v[1][0], v[1][1]); w.w = cvt_pk_bf16(v[1][2], v[1][3]);
                *(u32x4*)rowp = w; }
    }
};

template <class Epi, class Sched, bool ALIGN_EPI = false, bool SP2 = false>
__device__ __forceinline__ void gemm_phase(PG8_LAS unsigned char* lds, const Gemm g, const Sched& S, const Epi& E, const int wave_) {
    const int tid = otid(wave_), wid = wave_, lane = tid & 63, wr = wid >> 2, wc = wid & 3, fr = lane & 15, fq = lane >> 4;
    const int K = g.K, nt = K / BK;
    unsigned voffA[2], voffB[2];
#pragma unroll
    for (int i = 0; i < 2; ++i) { int R, C; stage_rc(tid * 16 + i * 8192, R, C); const int Rb = Epi::PERM ? ((R & ~31) + perm32(R & 31)) : R;
        voffA[i] = (unsigned)(R * K + C) * 2u; voffB[i] = (unsigned)(Rb * K + C) * 2u; }
    const size_t kstep = (size_t)(BK * 2);
    const size_t hstep = (size_t)HALF * K * 2;
    const size_t tstep = 2 * hstep;
    const unsigned ldsw = (unsigned)wid * 1024u;
    const int aoff = lds_byte(wr * 64 + fr, fq * 8), boff = lds_byte(wc * 32 + fr, fq * 8);
#define PG8_SA(b, h) (((b) * 2 + (h)) * HTB)
#define PG8_SB(b, h) ((4 + (b) * 2 + (h)) * HTB)
#define PG8_STAGE(bufoff, gbase, voff) do { _Pragma("unroll") for (int _i = 0; _i < 2; ++_i) \
        __builtin_amdgcn_global_load_lds((const unsigned*)((const char*)(gbase) + (voff)[_i]), (PG8_LAS unsigned*)(lds + (bufoff) + ldsw + _i * 8192), 16, 0, 0); } while (0)
#define PG8_LDA(dst, b, h) do { _Pragma("unroll") for (int m = 0; m < 4; ++m) _Pragma("unroll") for (int k = 0; k < 2; ++k) dst[m][k] = *(const PG8_LAS bf16x8*)(lds + PG8_SA(b, h) + aoff + m * 2048 + k * 1024); } while (0)
#define PG8_LDB(dst, b, h) do { _Pragma("unroll") for (int n = 0; n < 2; ++n) _Pragma("unroll") for (int k = 0; k < 2; ++k) dst[n][k] = *(const PG8_LAS bf16x8*)(lds + PG8_SB(b, h) + boff + n * 2048 + k * 1024); } while (0)
#define PG8_MMA(ai, bj, At, Bt) do { __builtin_amdgcn_s_setprio(1); _Pragma("unroll") for (int m = 0; m < 4; ++m) _Pragma("unroll") for (int n = 0; n < 2; ++n) _Pragma("unroll") for (int k = 0; k < 2; ++k) \
        acc[ai][bj][m][n] = __builtin_amdgcn_mfma_f32_16x16x32_bf16(Bt[n][k], At[m][k], acc[ai][bj][m][n], 0, 0, 0); __builtin_amdgcn_s_setprio(0); } while (0)
#define PG8_WAIT_V(n) asm volatile("s_waitcnt vmcnt(" #n ")" ::: "memory")
#define PG8_WAIT_L(n) asm volatile("s_waitcnt lgkmcnt(" #n ")" ::: "memory")
#define PG8_BAR __builtin_amdgcn_s_barrier()
#define PG8_SCHED __builtin_amdgcn_sched_barrier(0)
    Unit cur, nxt; int ui = 0;
    if (!S.next(0, cur)) return;
    f32x4 acc[2][2][4][2];
#pragma unroll
    for (int a = 0; a < 2; ++a)
#pragma unroll
        for (int b = 0; b < 2; ++b)
#pragma unroll
            for (int m = 0; m < 4; ++m)
#pragma unroll
                for (int n = 0; n < 2; ++n) acc[a][b][m][n] = (f32x4){0.f, 0.f, 0.f, 0.f};
    bf16x8 At[4][2], B0[2][2], B1[2][2];
    const char* cA = (const char*)g.A + (size_t)cur.pm * tstep; const char* cB = (const char*)g.Bt + (size_t)cur.pn * tstep;
    S.a_ready(cur);
    if constexpr (SP2) {
        PG8_STAGE(PG8_SB(0, 0), cB, voffB); PG8_STAGE(PG8_SB(0, 1), cB + hstep, voffB); PG8_STAGE(PG8_SA(0, 0), cA, voffA); PG8_STAGE(PG8_SA(0, 1), cA + hstep, voffA);
        if (wr == 1) PG8_BAR;
        PG8_WAIT_V(2); PG8_BAR;
        PG8_STAGE(PG8_SB(1, 0), cB + kstep, voffB); PG8_STAGE(PG8_SA(1, 0), cA + kstep, voffA); PG8_STAGE(PG8_SB(1, 1), cB + hstep + kstep, voffB);
        PG8_WAIT_V(6); PG8_BAR;
    } else {
        PG8_STAGE(PG8_SB(0, 0), cB, voffB); PG8_STAGE(PG8_SA(0, 0), cA, voffA); PG8_STAGE(PG8_SB(0, 1), cB + hstep, voffB); PG8_STAGE(PG8_SA(0, 1), cA + hstep, voffA);
        if (wr == 1) PG8_BAR;
        PG8_WAIT_V(4); PG8_BAR;
        PG8_STAGE(PG8_SB(1, 0), cB + kstep, voffB); PG8_STAGE(PG8_SA(1, 0), cA + kstep, voffA); PG8_STAGE(PG8_SB(1, 1), cB + hstep + kstep, voffB);
        PG8_WAIT_V(6); PG8_BAR;
    }
    for (;;) {
        const bool has_next = S.next(ui + 1, nxt);
        const char* nA = has_next ? (const char*)g.A + (size_t)nxt.pm * tstep : cA; const char* nB = has_next ? (const char*)g.Bt + (size_t)nxt.pn * tstep : cB;
        for (int t = 0; t < nt; t += 2) {
            const bool last = (t == nt - 2);
            const char* a1 = cA + (size_t)(t + 1) * kstep;
            const char* a2 = last ? nA : cA + (size_t)(t + 2) * kstep; const char* b2 = last ? nB : cB + (size_t)(t + 2) * kstep;
            const char* a3 = a2 + kstep; const char* b3 = b2 + kstep;
            if (last && has_next) S.a_ready(nxt);
            if constexpr (SP2) {
            PG8_LDB(B0, 0, 0); PG8_LDB(B1, 0, 1); PG8_SCHED; PG8_LDA(At, 0, 0); PG8_STAGE(PG8_SA(1, 1), a1 + hstep, voffA);
            PG8_WAIT_V(8); PG8_WAIT_L(0); PG8_BAR; PG8_MMA(0, 0, At, B0); PG8_MMA(0, 1, At, B1); PG8_BAR; PG8_SCHED;
            PG8_LDA(At, 0, 1); PG8_STAGE(PG8_SB(0, 0), b2, voffB); PG8_STAGE(PG8_SB(0, 1), b2 + hstep, voffB); PG8_STAGE(PG8_SA(0, 0), a2, voffA);
            PG8_WAIT_V(8); PG8_WAIT_L(0); PG8_BAR; PG8_MMA(1, 0, At, B0); PG8_MMA(1, 1, At, B1); PG8_BAR; PG8_SCHED;
            PG8_LDB(B0, 1, 0); PG8_LDB(B1, 1, 1); PG8_SCHED; PG8_LDA(At, 1, 0); PG8_STAGE(PG8_SA(0, 1), a2 + hstep, voffA);
            PG8_WAIT_V(8); PG8_WAIT_L(0); PG8_BAR; PG8_MMA(0, 0, At, B0); PG8_MMA(0, 1, At, B1); PG8_BAR; PG8_SCHED;
            PG8_LDA(At, 1, 1); PG8_STAGE(PG8_SB(1, 0), b3, voffB); PG8_STAGE(PG8_SB(1, 1), b3 + hstep, voffB); PG8_STAGE(PG8_SA(1, 0), a3, voffA);
            PG8_WAIT_V(8); PG8_WAIT_L(0); PG8_BAR; PG8_MMA(1, 0, At, B0); PG8_MMA(1, 1, At, B1); PG8_BAR; PG8_SCHED;
            } else {
            PG8_LDB(B0, 0, 0); PG8_SCHED; PG8_LDA(At, 0, 0); PG8_STAGE(PG8_SA(1, 1), a1 + hstep, voffA);
            PG8_WAIT_L(8); PG8_BAR; PG8_WAIT_L(0); PG8_MMA(0, 0, At, B0); PG8_BAR; PG8_SCHED;
            PG8_LDB(B1, 0, 1); PG8_STAGE(PG8_SB(0, 0), b2, voffB);
            PG8_BAR; PG8_WAIT_L(0); PG8_MMA(0, 1, At, B1); PG8_BAR;
            PG8_LDA(At, 0, 1); PG8_STAGE(PG8_SA(0, 0), a2, voffA);
            PG8_BAR; PG8_WAIT_L(0); PG8_MMA(1, 0, At, B0); PG8_BAR; PG8_SCHED;
            PG8_STAGE(PG8_SB(0, 1), b2 + hstep, voffB);
            PG8_WAIT_V(6); PG8_BAR; PG8_MMA(1, 1, At, B1); PG8_BAR;
            PG8_LDB(B0, 1, 0); PG8_SCHED; PG8_LDA(At, 1, 0); PG8_STAGE(PG8_SA(0, 1), a2 + hstep, voffA);
            PG8_WAIT_L(8); PG8_BAR; PG8_WAIT_L(0); PG8_MMA(0, 0, At, B0); PG8_BAR; PG8_SCHED;
            PG8_LDB(B1, 1, 1); PG8_STAGE(PG8_SB(1, 0), b3, voffB);
            PG8_BAR; PG8_WAIT_L(0); PG8_MMA(0, 1, At, B1); PG8_BAR;
            PG8_LDA(At, 1, 1); PG8_STAGE(PG8_SA(1, 0), a3, voffA);
            PG8_BAR; PG8_WAIT_L(0); PG8_MMA(1, 0, At, B0); PG8_BAR; PG8_SCHED;
            PG8_STAGE(PG8_SB(1, 1), b3 + hstep, voffB);
            PG8_WAIT_V(6); PG8_BAR; PG8_MMA(1, 1, At, B1); PG8_BAR;
            }
        }
        if constexpr (ALIGN_EPI) { if (wr == 0) PG8_BAR; }
        if constexpr (!Epi::AFTER_DRAIN) { E(acc, cur, wr, wc, fr, fq); S.done(cur); }
        if (!has_next) break;
#pragma unroll
        for (int a = 0; a < 2; ++a)
#pragma unroll
            for (int b = 0; b < 2; ++b)
#pragma unroll
                for (int m = 0; m < 4; ++m)
#pragma unroll
                    for (int n = 0; n < 2; ++n) acc[a][b][m][n] = (f32x4){0.f, 0.f, 0.f, 0.f};
        cur = nxt; cA = nA; cB = nB; ++ui;
        if constexpr (ALIGN_EPI) { if (wr == 1) PG8_BAR; }
    }
    PG8_WAIT_V(0);
    if constexpr (!ALIGN_EPI) { if (wr == 0) PG8_BAR; }
    PG8_BAR;
    if constexpr (Epi::AFTER_DRAIN) { E.fused(acc, cur, wr, wc, fr, fq, lds, wid, lane); S.done(cur); }
#undef PG8_SA
#undef PG8_SB
#undef PG8_STAGE
#undef PG8_LDA
#undef PG8_LDB
#undef PG8_MMA
#undef PG8_WAIT_V
#undef PG8_WAIT_L
#undef PG8_BAR
#undef PG8_SCHED
}
}

#define GAS __attribute__((address_space(1)))
#define LAS __attribute__((address_space(3)))
typedef unsigned short bf16;
typedef unsigned v4u __attribute__((ext_vector_type(4)));
typedef float f32x4 __attribute__((ext_vector_type(4)));
typedef short bf16x8 __attribute__((ext_vector_type(8)));
typedef GAS unsigned gu32;
typedef GAS unsigned long long gu64;
#define RLX_AGENT __ATOMIC_RELAXED, __HIP_MEMORY_SCOPE_AGENT
#define LDS_WAIT() asm volatile("s_waitcnt lgkmcnt(0)" ::: "memory")
#define VM_WAIT() asm volatile("s_waitcnt vmcnt(0)" ::: "memory")
__device__ __forceinline__ unsigned long long rt() { return __builtin_amdgcn_s_memrealtime(); }
__device__ __forceinline__ unsigned f2bf(float f) { unsigned u = __builtin_bit_cast(unsigned, f); return (u + 0x7fffu + ((u >> 16) & 1u)) >> 16; }
__device__ __forceinline__ unsigned pk2(float lo, float hi) { return f2bf(lo) | (f2bf(hi) << 16); }

#define XB_TMO      128
#define XB_XCNT(j)  (256  + 64 * (j))
#define XB_XSUB(j)  (1280 + 64 * (j))
#define XB_XGEN(j)  (2304 + 64 * (j))
#define XB_TOP      3328
#define XB_TOPGEN   3392
#define XCD_BAR_WORDS 3456
#define XB_SPIN_CAP (1u << 18)

__device__ __forceinline__ unsigned xb_ld(unsigned* p)              { return __hip_atomic_load(p, __ATOMIC_RELAXED, __HIP_MEMORY_SCOPE_AGENT); }
__device__ __forceinline__ unsigned xb_add(unsigned* p, unsigned v) { return __hip_atomic_fetch_add(p, v, __ATOMIC_RELAXED, __HIP_MEMORY_SCOPE_AGENT); }
__device__ __forceinline__ unsigned xb_xcc_id() { return (unsigned)__builtin_amdgcn_s_getreg((3 << 11) | 20) & 0xFu; }
#define XB_SPIN(cond, bar) do { unsigned _sp = 0; while (cond) { __builtin_amdgcn_s_sleep(1); \
    if ((++_sp & 255u) == 0u) { if (xb_ld(&(bar)[XB_TMO])) break; if (_sp > XB_SPIN_CAP) { atomicAdd(&(bar)[XB_TMO], 1u); break; } } } } while (0)

struct XcdBarrier {
    int wave;
    unsigned* bar; unsigned x;
    volatile LAS unsigned* st;
};

__device__ __forceinline__ XcdBarrier xcd_barrier_post(unsigned* bar, volatile LAS unsigned* st, int wave) {
    XcdBarrier b; b.wave = wave; b.bar = bar; b.x = xb_xcc_id(); b.st = st;
    if (wave == 0 && lane_id_() == 0) (void)xb_add(&bar[XB_XCNT(b.x)], 1u);
    return b;
}
__device__ __forceinline__ void xcd_barrier_complete(unsigned* bar, unsigned x, unsigned& nloc, unsigned& nx) {
    const unsigned G = gridDim.x * gridDim.y * gridDim.z;
    unsigned sum, cnt, mine, sp = 0u;
    for (;;) {
        sum = 0u; cnt = 0u; mine = 0u;
#pragma unroll
        for (unsigned j = 0; j < 16; ++j) { const unsigned c = xb_ld(&bar[XB_XCNT(j)]); sum += c; cnt += (c > 0u) ? 1u : 0u; mine = (j == x) ? c : mine; }
        if (sum == G) break;
        __builtin_amdgcn_s_sleep(1);
        if ((++sp & 255u) == 0u) { if (xb_ld(&bar[XB_TMO])) break; if (sp > XB_SPIN_CAP) { atomicAdd(&bar[XB_TMO], 1u); break; } }
    }
    nloc = mine > 0u ? mine : 1u; nx = cnt > 0u ? cnt : 1u;
}

__device__ __forceinline__ void xcd_barrier(const XcdBarrier& b) {
    asm volatile("s_waitcnt vmcnt(0)" ::: "memory");
    __syncthreads();
    if (b.wave == 0 && lane_id_() == 0) {
        unsigned* bar = b.bar;
        __builtin_amdgcn_s_waitcnt(0);
        unsigned nloc = b.st[0], nx = b.st[1];
        if (nloc == 0u) { xcd_barrier_complete(bar, b.x, nloc, nx); b.st[0] = nloc; b.st[1] = nx; }
        const unsigned old = xb_add(&bar[XB_XSUB(b.x)], 1u);
        const unsigned gen = old / nloc;
        if (old + 1u == (gen + 1u) * nloc) {
            __builtin_amdgcn_fence(__ATOMIC_RELEASE, "agent");
            asm volatile("s_waitcnt vmcnt(0)" ::: "memory");
            const unsigned og = xb_add(&bar[XB_TOP], 1u);
            const unsigned tg = og / nx;
            if (og + 1u == (tg + 1u) * nx) xb_add(&bar[XB_TOPGEN], 1u);
            else XB_SPIN(xb_ld(&bar[XB_TOPGEN]) == tg, bar);
            __builtin_amdgcn_fence(__ATOMIC_ACQUIRE, "agent");
            xb_add(&bar[XB_XGEN(b.x)], 1u);
            asm volatile("s_waitcnt vmcnt(0)" ::: "memory");
        } else {
            XB_SPIN(xb_ld(&bar[XB_XGEN(b.x)]) == gen, bar);
            __builtin_amdgcn_fence(__ATOMIC_ACQUIRE, "agent");
            asm volatile("s_waitcnt vmcnt(0)" ::: "memory");
        }
    }
    __syncthreads();
}

__device__ __forceinline__ void xcd_barrier_local(const XcdBarrier& b) {
    asm volatile("s_waitcnt vmcnt(0)" ::: "memory");
    __syncthreads();
    if (b.wave == 0 && lane_id_() == 0) {
        unsigned* bar = b.bar;
        __builtin_amdgcn_s_waitcnt(0);
        const unsigned nloc = b.st[0];
        const unsigned old = xb_add(&bar[XB_XSUB(b.x)], 1u);
        const unsigned gen = old / nloc;
        if (old + 1u == (gen + 1u) * nloc) xb_add(&bar[XB_XGEN(b.x)], 1u);
        else XB_SPIN(xb_ld(&bar[XB_XGEN(b.x)]) == gen, bar);
        __builtin_amdgcn_fence(__ATOMIC_ACQUIRE, "agent");
        asm volatile("s_waitcnt vmcnt(0)" ::: "memory");
    }
    __syncthreads();
}

constexpr int NWAVES = 8;
#ifndef MK_PER_PHASE
#define MK_PER_PHASE 0
#endif
constexpr int BATCH = 4, T = 8192, D = 1024, M = BATCH * T;
constexpr int MEML = 256, MROWS = BATCH * MEML;
constexpr int AW = 512, HD = 128, NIH = 16, IDIM = 64;
constexpr int TOPK = 256;
constexpr int NIN = 3152, NINP = 3328;
constexpr int DFF = 2816, CW = 31, CHD = 256;
constexpr float EPS = 1e-6f;

constexpr size_t MiB = 1u << 20;
constexpr size_t WS_CTL = 0, CTL_ZERO_BYTES = 1 * MiB;
constexpr size_t WS_WIN = 1 * MiB;
constexpr size_t WS_WOUT = 8 * MiB;
constexpr size_t WS_WCIN = 10 * MiB;
constexpr size_t WS_WCOUT = 14 * MiB;
constexpr size_t WS_WCQ = 16 * MiB;
constexpr size_t WS_WCO = 20 * MiB;
constexpr size_t WS_WCKV = 24 * MiB;
constexpr size_t WS_WGU = 32 * MiB;
constexpr size_t WS_WDN = 54 * MiB;
constexpr size_t WS_MEMN = 65 * MiB;
constexpr size_t WS_MKV = 69 * MiB;
constexpr size_t WS_XN = 80 * MiB;
constexpr size_t WS_BM = 144 * MiB;
constexpr size_t WS_PROJ = 176 * MiB;
constexpr size_t PROJ_T = (size_t)M * 256 * 2;
constexpr size_t WS_HID = WS_PROJ;
constexpr size_t WS_CQ = WS_PROJ;
constexpr size_t WS_CO = WS_PROJ + 64 * MiB;
constexpr size_t WS_G = WS_PROJ;
constexpr size_t WS_IKT = WS_PROJ + 13 * PROJ_T;
constexpr size_t WS_HB2 = WS_IKT + 4 * MiB;
constexpr size_t WS_SSQ = WS_HB2 + 64 * MiB;
constexpr size_t SSQ_BYTES = (size_t)M * 16 * 4;
constexpr size_t WS_END = WS_SSQ + 5 * SSQ_BYTES;
constexpr int CW_TMO = 0, CW_MIS = 64, CW_D1Q = 128, CW_BAR = 4096;

constexpr int RING_OFF = 0, RING_BYTES = 131072;
constexpr int LDSCTL_OFF = RING_BYTES, MISC_OFF = LDSCTL_OFF + 320;
constexpr int LDS_BYTES = 147456;

namespace dsa2 {
constexpr int D = 128, LDQ = 256, LDO = 1024, MWT = 8192;
constexpr float THR = 8.f;
constexpr bool WSKIP = false;

constexpr float SCALE = 0.08838834764831845f;
constexpr int NW = 8, QBLK = 32, KVBLK = 64, QB = NW * QBLK;
constexpr int SHM_V = KVBLK * D * 2, SHM_K = KVBLK * D * 2;
constexpr int LDS_BYTES = 2 * SHM_V + 2 * SHM_K + NW * 64 * 4;
typedef short s16x4 __attribute__((ext_vector_type(4)));
typedef float f32x16 __attribute__((ext_vector_type(16)));
typedef unsigned u32x4 __attribute__((ext_vector_type(4)));
template <class A, class Bt> struct same_t { static constexpr bool v = false; };
template <class A> struct same_t<A, A> { static constexpr bool v = true; };

#define KSWZ(row, colB) ((row) * 256 + ((colB) ^ (((row) & 7) << 4)))
#define SBAR() __builtin_amdgcn_sched_barrier(0)
__device__ __forceinline__ int v_st(int k, int c) { const int kk = (k & ~0xC) | ((k & 4) << 1) | ((k & 8) >> 1); return ((kk >> 3) * 4 + (c >> 5)) * 512 + ((kk & 7) * 32 + (c & 31)) * 2; }
__device__ __forceinline__ int v_rd_base(int lane) { return ((lane & 3) << 3) | (((lane >> 2) & 3) << 6) | (((lane >> 4) & 1) << 5) | (((lane >> 5) & 1) << 8); }
constexpr int v_rd_off(int d0, int ks, int half) { return d0 * 512 + ks * 4096 + half * 2048; }
__device__ __forceinline__ int crow(int r, int hi) { return (r & 3) + 8 * (r >> 2) + 4 * hi; }
__device__ __forceinline__ unsigned cvtpk(float lo, float hi) {
    unsigned r; asm volatile("v_cvt_pk_bf16_f32 %0, %1, %2" : "=v"(r) : "v"(lo), "v"(hi)); return r;
}
__device__ __forceinline__ bf16x8 pack8(f32x4 a, f32x4 b) {
    u32x4 w = {cvtpk(a[0], a[1]), cvtpk(a[2], a[3]), cvtpk(b[0], b[1]), cvtpk(b[2], b[3])};
    return *reinterpret_cast<bf16x8*>(&w);
}
template <class T> __device__ __forceinline__ bf16x8 load8(const T* p) {
    if constexpr (same_t<T, float>::v) { return pack8(*(const f32x4*)p, *(const f32x4*)(p + 4)); }
    else { return *reinterpret_cast<const bf16x8*>(p); }
}
__device__ __forceinline__ void mask_tile(f32x16& p0, f32x16& p1, int dq, unsigned W) {
    const float NEG = -__builtin_inff();
#pragma unroll
    for (int r = 0; r < 16; ++r) {
        const int c = (r & 3) + 8 * (r >> 2);
        if ((unsigned)(dq - c) >= W) p0[r] = NEG;
        if ((unsigned)(dq - c - 32) >= W) p1[r] = NEG;
    }
}
__device__ __forceinline__ void mask_bits(f32x16& p0, f32x16& p1, unsigned mh, int hi) {
    const float NEG = -__builtin_inff();
    auto rr = __builtin_amdgcn_permlane32_swap(mh, mh, false, false);
    const unsigned lo = (unsigned)rr[0] >> (4 * hi), hh = (unsigned)rr[1] >> (4 * hi);
#pragma unroll
    for (int r = 0; r < 16; ++r) {
        const int c = (r & 3) + 8 * (r >> 2);
        if (!((lo >> c) & 1u)) p0[r] = NEG;
        if (!((hh >> c) & 1u)) p1[r] = NEG;
    }
}
__device__ __forceinline__ void partialSM_s(f32x16& p0, f32x16& p1, float& m_reg, float& mn, float& alpha, const float SCALE) {
    float pmax = p0[0]; for (int r = 1; r < 16; ++r) pmax = fmaxf(pmax, p0[r]); for (int r = 0; r < 16; ++r) pmax = fmaxf(pmax, p1[r]);
    { auto rr = __builtin_amdgcn_permlane32_swap(__float_as_uint(pmax), __float_as_uint(pmax), false, false);
      pmax = fmaxf(__uint_as_float(rr[0]), __uint_as_float(rr[1])); }
    const float C2 = 1.4426950408889634f * SCALE;
    if (__builtin_expect(__all((pmax - m_reg) * SCALE <= THR), 1)) { mn = m_reg; alpha = 1.f; }
    else { mn = fmaxf(m_reg, pmax); alpha = __builtin_amdgcn_exp2f((m_reg - mn) * C2); m_reg = mn; }
    const float mnL = -mn * C2;
    for (int r = 0; r < 16; ++r) p0[r] = fmaf(p0[r], C2, mnL); for (int r = 0; r < 16; ++r) p1[r] = fmaf(p1[r], C2, mnL);
    for (int r = 0; r < 16; ++r) p0[r] = __builtin_amdgcn_exp2f(p0[r]);
}
__device__ __forceinline__ void partialSM(f32x16& p0, f32x16& p1, float& m_reg, float& mn, float& alpha) { partialSM_s(p0, p1, m_reg, mn, alpha, SCALE); }
__device__ __forceinline__ void finishSM(f32x16& p0, f32x16& p1, float alpha, float& l_reg, bf16x8& pa0, bf16x8& pa1, bf16x8& pa2, bf16x8& pa3) {
    for (int r = 0; r < 16; ++r) p1[r] = __builtin_amdgcn_exp2f(p1[r]);
    float ps = 0; for (int r = 0; r < 16; ++r) ps += p0[r]; for (int r = 0; r < 16; ++r) ps += p1[r];
    { auto rr = __builtin_amdgcn_permlane32_swap(__float_as_uint(ps), __float_as_uint(ps), false, false);
      ps = __uint_as_float(rr[0]) + __uint_as_float(rr[1]); }
    l_reg = l_reg * alpha + ps;
#define PK4(P, B_, OUT) do { unsigned a0 = cvtpk(P[B_+0], P[B_+1]), a1 = cvtpk(P[B_+2], P[B_+3]);                          \
        unsigned b0 = cvtpk(P[B_+4], P[B_+5]), b1 = cvtpk(P[B_+6], P[B_+7]);                                             \
        auto r0 = __builtin_amdgcn_permlane32_swap(a0, b0, false, false); auto r1 = __builtin_amdgcn_permlane32_swap(a1, b1, false, false); \
        u32x4 w = {r0[0], r1[0], r0[1], r1[1]}; OUT = *reinterpret_cast<bf16x8*>(&w); } while (0)
    PK4(p0, 0, pa0); PK4(p0, 8, pa1); PK4(p1, 0, pa2); PK4(p1, 8, pa3);
#undef PK4
}
template <int KB, bool SK>
__device__ __forceinline__ void qkt(f32x16& p0, f32x16& p1, const char* K_lds, int r32, int hi, const bf16x8* qr, bool act) {
    if (SK && !act) { const float NEG = -__builtin_inff();
#pragma unroll
        for (int r = 0; r < 16; ++r) { p0[r] = NEG; p1[r] = NEG; } return; }
    p0 = f32x16{}; p1 = f32x16{};
    const char* kb[4];
#pragma unroll
    for (int dd = 0; dd < 4; ++dd) kb[dd] = K_lds + KB * SHM_K + KSWZ(r32, (dd * 16 + hi * 8) * 2);
#pragma unroll
    for (int d0 = 0; d0 < 8; ++d0) { const char* a = kb[d0 & 3] + (d0 >> 2) * 128;
        bf16x8 b0 = *reinterpret_cast<const bf16x8*>(a);
        bf16x8 b1 = *reinterpret_cast<const bf16x8*>(a + 32 * 256);
        p0 = __builtin_amdgcn_mfma_f32_32x32x16_bf16(b0, qr[d0], p0, 0, 0, 0);
        p1 = __builtin_amdgcn_mfma_f32_32x32x16_bf16(b1, qr[d0], p1, 0, 0, 0); }
}
template <int VB, bool SK>
__device__ __forceinline__ void pv_tile(f32x16* o, int vb0, bf16x8 pa0, bf16x8 pa1, bf16x8 pa2, bf16x8 pa3, bool act) {
    if (SK && !act) return;
#define TRRD(dst, off) asm volatile("ds_read_b64_tr_b16 %0, %1 offset:%2" : "=&v"(dst) : "v"(vb0), "i"(off) : "memory")
#define PV_D0(d0) do { s16x4 l0, l1, l2, l3, h0, h1, h2, h3; constexpr int b_ = VB * SHM_V + v_rd_off(d0, 0, 0);     \
        TRRD(l0, b_); TRRD(h0, b_ + 2048); TRRD(l1, b_ + 4096); TRRD(h1, b_ + 6144); TRRD(l2, b_ + 8192); TRRD(h2, b_ + 10240); TRRD(l3, b_ + 12288); TRRD(h3, b_ + 14336); \
        asm volatile("s_waitcnt lgkmcnt(0)" ::: "memory"); SBAR();                 \
        o[d0] = __builtin_amdgcn_mfma_f32_32x32x16_bf16(pa0, (bf16x8){l0[0], l0[1], l0[2], l0[3], h0[0], h0[1], h0[2], h0[3]}, o[d0], 0, 0, 0);   \
        o[d0] = __builtin_amdgcn_mfma_f32_32x32x16_bf16(pa1, (bf16x8){l1[0], l1[1], l1[2], l1[3], h1[0], h1[1], h1[2], h1[3]}, o[d0], 0, 0, 0);   \
        o[d0] = __builtin_amdgcn_mfma_f32_32x32x16_bf16(pa2, (bf16x8){l2[0], l2[1], l2[2], l2[3], h2[0], h2[1], h2[2], h2[3]}, o[d0], 0, 0, 0);   \
        o[d0] = __builtin_amdgcn_mfma_f32_32x32x16_bf16(pa3, (bf16x8){l3[0], l3[1], l3[2], l3[3], h3[0], h3[1], h3[2], h3[3]}, o[d0], 0, 0, 0); } while (0)
    PV_D0(0); PV_D0(1); PV_D0(2); PV_D0(3);
#undef PV_D0
#undef TRRD
}

template <class TIn, class TOut> struct BlockRef { const TIn* Q; const TIn* K; const TIn* V; TOut* O; const unsigned long long* MW; int P0; };
template <class TIn> struct Seam {
    bf16x8 qr[8];
    bf16x8 st_k0, st_k1;
    f32x4 tq[1];
};
__device__ __forceinline__ int swa_jlo(int P0, int W) { const int lowk = P0 - W + 1; return lowk > 0 ? lowk / KVBLK : 0; }
#define ROW(p, k0, rr) ((p) + (size_t)((k0) + (rr)) * LDQ + sc)
#define VMW() asm volatile("s_waitcnt vmcnt(0)" ::: "memory")
#define VMWN(n) asm volatile("s_waitcnt vmcnt(%0)" :: "i"(n) : "memory")
#define SLOAD_H(Kp, Vp, k0) do { S.st_v0 = load8<TIn>(ROW(Vp, k0, sr)); S.st_v1 = load8<TIn>(ROW(Vp, k0, 32 + sr));              \
                         S.st_k0 = load8<TIn>(ROW(Kp, k0, sr)); S.st_k1 = load8<TIn>(ROW(Kp, k0, 32 + sr)); } while (0)
#define SWRITE_HK(bf) do { *(bf16x8*)(K_lds + (bf) * SHM_K + kws) = S.st_k0; *(bf16x8*)(K_lds + (bf) * SHM_K + kws + 32 * 256) = S.st_k1; } while (0)
#define SWRITE_HV(bf) do { *(bf16x8*)(V_lds + (bf) * SHM_V + vst0) = S.st_v0; *(bf16x8*)(V_lds + (bf) * SHM_V + vst1) = S.st_v1; } while (0)
#define SWRITE_H(bf) do { SWRITE_HV(bf); SWRITE_HK(bf); } while (0)
#define SLOAD_F(p, k0) do { S.st_k0 = load8<TIn>(ROW(p, k0, sr)); S.st_k1 = load8<TIn>(ROW(p, k0, 32 + sr)); } while (0)
#define SWRITE_KF(bf) do { *(bf16x8*)(K_lds + (bf) * SHM_K + kws) = S.st_k0; *(bf16x8*)(K_lds + (bf) * SHM_K + kws + 32 * 256) = S.st_k1; } while (0)
#define SWRITE_VF(bf) do { *(bf16x8*)(V_lds + (bf) * SHM_V + vst0) = S.st_k0; *(bf16x8*)(V_lds + (bf) * SHM_V + vst1) = S.st_k1; } while (0)
template <class TIn, class TOut>
__device__ __forceinline__ void causal_swa_prime(const BlockRef<TIn, TOut>& cur, int W, char* lds, Seam<TIn>& S, const int wave_) {
    constexpr bool F32 = same_t<TIn, float>::v; constexpr bool TWOPH = true; static_assert(!F32, "bf16 K/V only");
    const int tid = otid(wave_), wid = wave_, lane = tid & 63, r32 = lane & 31, hi = lane >> 5;
    const int sr = tid >> 4, sc = (tid & 15) * 8, kws = KSWZ(sr, sc * 2); char* K_lds = lds + 2 * SHM_V;
    const int kb0 = swa_jlo(cur.P0, W) * KVBLK;
    for (int d0 = 0; d0 < 8; ++d0) S.qr[d0] = load8<TIn>(cur.Q + (size_t)(wid * QBLK + r32) * LDQ + d0 * 16 + hi * 8);
    if constexpr (TWOPH) { SLOAD_F((cur.K), kb0); VMW(); SWRITE_KF(0); SBAR(); SLOAD_F((cur.V), kb0); }
    else { SLOAD_H(cur.K, cur.V, kb0); VMW(); SWRITE_HK(0); }
    __syncthreads();
}
template <class TIn, class TOut>
__device__ __forceinline__ void causal_swa_block(const BlockRef<TIn, TOut>& cur, const BlockRef<TIn, TOut>& nxt, int skv, int W, char* lds, Seam<TIn>& S, const int wave_) {
    constexpr bool F32 = same_t<TIn, float>::v;
    const int tid = otid(wave_), wid = wave_, lane = tid & 63, r32 = lane & 31, hi = lane >> 5;
    const int j_lo = swa_jlo(cur.P0, W);
    int j_hi = (cur.P0 + QB - 1) / KVBLK + 1; if (j_hi > skv / KVBLK) j_hi = skv / KVBLK;
    const int NT = j_hi - j_lo;
    const int kbn = swa_jlo(nxt.P0, W) * KVBLK;
    const int qlo = cur.P0 + wid * QBLK, qm = qlo + r32 - 4 * hi;
    char* V_lds = lds; char* K_lds = lds + 2 * SHM_V;
    float* ws = (float*)(lds + 2 * SHM_V + 2 * SHM_K) + wid * 64; float* li_l = ws, * al_l = ws + 32;
    float m_reg = -1e30f, l_reg = 0; f32x16 o[4] = {};
    const int sr = tid >> 4, sc = (tid & 15) * 8, vst0 = v_st(sr, sc), vst1 = v_st(32 + sr, sc), kws = KSWZ(sr, sc * 2);
    const int vb0 = (int)(uintptr_t)V_lds + v_rd_base(lane);
    const TIn* Kh = cur.K; const TIn* Vh = cur.V;
#define RESC(a) do { if (__any((a) < 1.f)) { if (hi == 0) al_l[r32] = (a); asm volatile("s_waitcnt lgkmcnt(0)" ::: "memory");              \
                     for (int d_ = 0; d_ < 4; ++d_) for (int r = 0; r < 16; ++r) o[d_][r] *= al_l[crow(r, hi)]; } } while (0)
#define KBASE(t) ((j_lo + (t)) * KVBLK)
#define ACT(t) (KBASE(t) <= qlo + QBLK - 1 && KBASE(t) + KVBLK - 1 >= qlo - W + 1)
#define MASKT(P0_, P1_, t, MWX) do { mask_bits(P0_, P1_, MWX, hi); } while (0)
#define MWLD(t) (((const unsigned*)cur.MW)[((size_t)(j_lo + (t)) * MWT + qlo + r32) * 2 + hi])
    constexpr int NQL = F32 ? 16 : 8; constexpr bool TWOPH = true;
    constexpr bool SK = WSKIP && !F32;
#define SEAM_K0() do { VMWN(NQL); if constexpr (TWOPH) { SWRITE_KF(0); SBAR(); SLOAD_F((nxt.V), kbn); } else { SWRITE_HK(0); } SBAR(); } while (0)
    f32x16 pA0, pA1, pB0, pB1; float mnA, mnB, alA, alB; bf16x8 pa0, pa1, pa2, pa3;
    if constexpr (TWOPH) { VMW(); SWRITE_VF(0); SBAR(); } else { SWRITE_HV(0); SBAR(); }
    if (NT > 1) { if constexpr (TWOPH) SLOAD_F((Kh), KBASE(1)); else SLOAD_H(Kh, Vh, KBASE(1)); }
    unsigned mwA = MWLD(0); SBAR();     qkt<0, SK>(pA0, pA1, K_lds, r32, hi, S.qr, ACT(0));
    if constexpr (TWOPH) { if (NT > 1) { VMW(); SWRITE_KF(1); SBAR(); SLOAD_F((Vh), KBASE(1)); } }
    MASKT(pA0, pA1, 0, mwA); partialSM(pA0, pA1, m_reg, mnA, alA);
    if (NT > 1) { VMW(); if constexpr (TWOPH) { SWRITE_VF(1); SBAR(); if (NT > 2) SLOAD_F((Kh), KBASE(2)); } else SWRITE_H(1); }
    __syncthreads();
#define HALF_STEP(PX0, PX1, mnX, alX, PY0, PY1, alY, t, KB, VB, SB, MWX) do {                                                 \
        MWX = MWLD(t); SBAR(); qkt<KB, SK>(PX0, PX1, K_lds, r32, hi, S.qr, ACT(t));                              \
        finishSM(PY0, PY1, alY, l_reg, pa0, pa1, pa2, pa3); SBAR();                                                           \
        if ((t) + 1 < NT) { if constexpr (TWOPH) { VMW(); SWRITE_KF(SB); SBAR(); SLOAD_F((Vh), KBASE((t) + 1)); }  \
                            else { SLOAD_H(Kh, Vh, KBASE((t) + 1)); } SBAR(); }                                               \
        pv_tile<VB, SK>(o, vb0, pa0, pa1, pa2, pa3, ACT((t) - 1)); MASKT(PX0, PX1, (t), MWX); partialSM(PX0, PX1, m_reg, mnX, alX);                                        \
        __syncthreads();                                                                                                      \
        if ((t) + 1 < NT) { VMW(); if constexpr (TWOPH) { SWRITE_VF(SB); SBAR(); if ((t) + 2 < NT) SLOAD_F((Kh), KBASE((t) + 2)); } \
                            else { SWRITE_H(SB); } }                                                                          \
        RESC(alX); __syncthreads(); } while (0)
    for (int t = 1; t + 1 < NT; t += 2) {
        HALF_STEP(pB0, pB1, mnB, alB, pA0, pA1, alA, t, 1, 0, 0, mwA);
        HALF_STEP(pA0, pA1, mnA, alA, pB0, pB1, alB, t + 1, 0, 1, 1, mwA);
    }
    const bool even = (NT & 1) == 0;
    if (even) { mwA = MWLD(NT - 1); SBAR(); qkt<1, SK>(pB0, pB1, K_lds, r32, hi, S.qr, ACT(NT - 1)); SBAR(); }
#define QROW(e) (nxt.Q + (size_t)(wid * QBLK + r32) * LDQ + ((e) >> 1) * 16 + hi * 8 + ((e) & 1) * 4)
    if constexpr (F32) { SBAR();
#pragma unroll
        for (int e = 0; e < 8; ++e) S.tq[e] = *(const f32x4*)QROW(e); }
    else { SLOAD_F((nxt.K), kbn); SBAR();
#pragma unroll
        for (int d0 = 0; d0 < 8; ++d0) S.qr[d0] = load8<TIn>(nxt.Q + (size_t)(wid * QBLK + r32) * LDQ + d0 * 16 + hi * 8); }
    SBAR();
    finishSM(pA0, pA1, alA, l_reg, pa0, pa1, pa2, pa3); SBAR();
    if constexpr (F32) {
#pragma unroll
        for (int e = 8; e < 16; ++e) S.tq[e] = *(const f32x4*)QROW(e); SBAR(); }
#undef QROW
    pv_tile<0, SK>(o, vb0, pa0, pa1, pa2, pa3, ACT(even ? NT - 2 : NT - 1));
    if (even) { MASKT(pB0, pB1, NT - 1, mwA); partialSM(pB0, pB1, m_reg, mnB, alB); __syncthreads(); RESC(alB);
        finishSM(pB0, pB1, alB, l_reg, pa0, pa1, pa2, pa3); SBAR(); pv_tile<1, SK>(o, vb0, pa0, pa1, pa2, pa3, ACT(NT - 1)); }
    SBAR(); SEAM_K0();
    if (hi == 0) li_l[r32] = l_reg; asm volatile("s_waitcnt lgkmcnt(0)" ::: "memory");
    float rli[16];
#pragma unroll
    for (int r = 0; r < 16; ++r) rli[r] = __builtin_amdgcn_rcpf(li_l[crow(r, hi)]);
    TOut* Ow = cur.O + (size_t)(wid * QBLK) * LDO;
#pragma unroll
    for (int r = 0; r < 16; ++r) { const int orow = crow(r, hi);
#pragma unroll
        for (int d0 = 0; d0 < 4; ++d0) { const float v = o[d0][r] * rli[r];
            if constexpr (same_t<TOut, float>::v) { Ow[(size_t)orow * LDO + d0 * 32 + r32] = v; }
            else { const float vn = __shfl_xor(v, 1);
                   if ((r32 & 1) == 0) *(unsigned*)(Ow + (size_t)orow * LDO + d0 * 32 + r32) = cvtpk(v, vn); } } }
    if constexpr (F32) {
#pragma unroll
        for (int d0 = 0; d0 < 8; ++d0) S.qr[d0] = pack8(S.tq[2 * d0], S.tq[2 * d0 + 1]); }
    __syncthreads();
#undef RESC
#undef KBASE
#undef ACT
#undef MASKT
#undef MWLD
#undef SEAM_K0
#undef HALF_STEP
}
#undef ROW
#undef VMW
#undef VMWN
#undef SLOAD_H
#undef SWRITE_HK
#undef SWRITE_HV
#undef SWRITE_H
#undef SLOAD_F
#undef SWRITE_KF
#undef SWRITE_VF


}

typedef float f32x16 __attribute__((ext_vector_type(16)));
typedef float f32x2 __attribute__((ext_vector_type(2)));
typedef unsigned long long u64;
struct Frame {
    LAS unsigned char* lds;
    volatile LAS unsigned* MISC;
    gu32* ctl;
    int tid, lane, wave, G;
};
__device__ __forceinline__ float wave_sum_dpp(float v) {
#define WS_DPP(ctrl, rmask) v += __builtin_bit_cast(float, __builtin_amdgcn_update_dpp(0, __builtin_bit_cast(int, v), ctrl, rmask, 0xf, true))
    WS_DPP(0xB1, 0xf); WS_DPP(0x4E, 0xf); WS_DPP(0x141, 0xf); WS_DPP(0x140, 0xf); WS_DPP(0x142, 0xa); WS_DPP(0x143, 0xc);
#undef WS_DPP
    return __builtin_bit_cast(float, __builtin_amdgcn_readlane(__builtin_bit_cast(int, v), 63));
}
__device__ __forceinline__ float wave_sum(float v) {
#pragma unroll
    for (int o = 1; o < 64; o <<= 1) v += __shfl_xor(v, o);
    return v;
}
__device__ __forceinline__ int wave_sum_i(int v) {
#pragma unroll
    for (int o = 1; o < 64; o <<= 1) v += __shfl_xor(v, o);
    return __builtin_amdgcn_readfirstlane(v);
}
__device__ __forceinline__ float bf_lo(unsigned u) { return __uint_as_float(u << 16); }
__device__ __forceinline__ float bf_hi(unsigned u) { return __uint_as_float(u & 0xffff0000u); }

__device__ __forceinline__ void tr_item(const float* W, int ldw, int nvalid, int k0, int n0, bf16* WT, int ldk, int drow0, int kcol0, LAS float* scr, int lane, const float* kgain = nullptr) {
    const int kr = lane >> 3, n4 = (lane & 7) * 4; const bool ok = n0 + n4 < nvalid;
    f32x4 v[8];
#pragma unroll
    for (int i = 0; i < 8; ++i) v[i] = ok ? *(const f32x4*)(W + (size_t)(k0 + 8 * i + kr) * ldw + n0 + n4) : (f32x4){0.f, 0.f, 0.f, 0.f};
#pragma unroll
    for (int i = 0; i < 8; ++i) { const int kk = 8 * i + kr; const float g = kgain ? kgain[k0 + kk] : 1.f;
#pragma unroll
        for (int j = 0; j < 4; ++j) scr[kk * 33 + n4 + j] = v[i][j] * g; }
    LDS_WAIT(); asm volatile("" ::: "memory");
    const int c = lane & 7;
#pragma unroll
    for (int j = 0; j < 4; ++j) { const int n = (lane >> 3) + 8 * j; const LAS float* s = scr + (8 * c) * 33 + n;
        v4u o; o.x = pk2(s[0 * 33], s[1 * 33]); o.y = pk2(s[2 * 33], s[3 * 33]); o.z = pk2(s[4 * 33], s[5 * 33]); o.w = pk2(s[6 * 33], s[7 * 33]);
        *(GAS v4u*)(WT + (size_t)(drow0 + n) * ldk + kcol0 + k0 + 8 * c) = o; }
    LDS_WAIT(); asm volatile("" ::: "memory");
}
__device__ __forceinline__ void rms_row_to_bf16(int lane, const float* xrow, const float* gain, bf16* orow) {
    const GAS f32x4* xr = (const GAS f32x4*)xrow + lane; const GAS f32x4* gr = (const GAS f32x4*)gain + lane;
    f32x4 v[4]; float s = 0.f;
#pragma unroll
    for (int j = 0; j < 4; ++j) { v[j] = xr[64 * j]; s += (v[j].x * v[j].x + v[j].y * v[j].y) + (v[j].z * v[j].z + v[j].w * v[j].w); }
    const float r = 1.f / sqrtf(wave_sum(s) * (1.f / D) + EPS);
    GAS u64* o8 = (GAS u64*)orow + lane;
#pragma unroll
    for (int j = 0; j < 4; ++j) { const f32x4 g = gr[64 * j]; o8[64 * j] = (u64)pk2(v[j].x * r * g.x, v[j].y * r * g.y) | ((u64)pk2(v[j].z * r * g.z, v[j].w * r * g.w) << 32); }
}
struct P0Args { const float *norm_cross, *norm_ffn; const float *x, *mem, *norm_mix, *norm_mem, *w_in_ab, *pool_w, *pool_scale, *w_out_ab, *conv_w_in, *conv_w_out, *cross_wq, *cross_wk, *cross_wv, *cross_wo, *ffn_w_gate, *ffn_w_up, *ffn_w_down; unsigned char* ws; };
__device__ __forceinline__ void p0_prologue(Frame& F, const P0Args& a) {
    LAS float* scr = (LAS float*)(F.lds + RING_OFF + F.wave * 16384);
    const int gw = blockIdx.x * NWAVES + F.wave, NGW = F.G * NWAVES, lane = otid(F.wave) & 63;
    unsigned char* ws = a.ws;
    constexpr int I_IN = 16 * (NINP / 32), I_OUTA = 8 * 32, I_CIN = 16 * 64, I_SQ = 16 * 32, I_GU = 16 * (DFF / 32), I_DN = (DFF / 64) * 32;
    constexpr int NITEMS = I_IN + I_OUTA + I_CIN + I_SQ + 8 * I_SQ + 4 * I_GU + 2 * I_DN;
    for (int it = gw; it < NITEMS; it += NGW) {
        int r = it;
        if (r < I_IN) { const int nb = NINP / 32, kb = r / nb, n0 = 32 * (r % nb); tr_item(a.w_in_ab, NIN, NIN, 64 * kb, n0, (bf16*)(ws + WS_WIN), D, n0, 0, scr, lane); continue; } r -= I_IN;
        if (r < I_OUTA) { const int kb = r / 32, n0 = 32 * (r % 32); tr_item(a.w_out_ab, D, D, 64 * kb, n0, (bf16*)(ws + WS_WOUT), D, n0, 0, scr, lane); continue; } r -= I_OUTA;
        if (r < I_CIN) { const int kb = r / 64, n0 = 32 * (r % 64), c = n0 & 1023, dr = 256 * (c >> 7) + (c & 127) + ((n0 >> 10) << 7); tr_item(a.conv_w_in, 2 * D, 2 * D, 64 * kb, n0, (bf16*)(ws + WS_WCIN), D, dr, 0, scr, lane, a.norm_mix + D); continue; } r -= I_CIN;
        if (r < I_SQ) { const int kb = r / 32, n0 = 32 * (r % 32); tr_item(a.conv_w_out, D, D, 64 * kb, n0, (bf16*)(ws + WS_WCOUT), D, n0, 0, scr, lane); continue; } r -= I_SQ;
        if (r < 8 * I_SQ) { const int mi = r / I_SQ, l = mi >> 2, which = mi & 3, q = r % I_SQ, kb = q / 32, n0 = 32 * (q % 32);
            const float* src = (which == 0 ? a.cross_wq : which == 1 ? a.cross_wk : which == 2 ? a.cross_wv : a.cross_wo) + (size_t)l * D * D;
            bf16* dst = which == 0 ? (bf16*)(ws + WS_WCQ) + (size_t)l * D * D : which == 3 ? (bf16*)(ws + WS_WCO) + (size_t)l * D * D : (bf16*)(ws + WS_WCKV) + (size_t)l * 2 * D * D + (which == 2 ? (size_t)D * D : 0);
            tr_item(src, D, D, 64 * kb, n0, dst, D, n0, 0, scr, lane, which == 0 ? a.norm_cross + l * D : nullptr); continue; } r -= 8 * I_SQ;
        if (r < 4 * I_GU) { const int mi = r / I_GU, l = mi >> 1, up = mi & 1, q = r % I_GU, nb = DFF / 32, kb = q / nb, n0 = 32 * (q % nb), dr = 256 * (n0 >> 7) + (n0 & 127) + 128 * up;
            const float* src = (up ? a.ffn_w_up : a.ffn_w_gate) + (size_t)l * D * DFF;
            tr_item(src, DFF, DFF, 64 * kb, n0, (bf16*)(ws + WS_WGU) + (size_t)l * 2 * DFF * D, D, dr, 0, scr, lane, a.norm_ffn + l * D); continue; } r -= 4 * I_GU;
        { const int l = r / I_DN, q = r % I_DN, kb = q / 32, n0 = 32 * (q % 32);
            tr_item(a.ffn_w_down + (size_t)l * DFF * D, D, D, 64 * kb, n0, (bf16*)(ws + WS_WDN) + (size_t)l * D * DFF, DFF, n0, 0, scr, lane); }
    }
    for (int it = gw; it < 128 * 16; it += NGW) {
        const int cc = (it >> 4) * 4, n = (it & 15) * 64 + lane, g = cc >> 7;
        const float* pw = a.pool_w + (size_t)cc * 128; const float* ps = a.pool_scale + g * 128; const float* wo = a.w_out_ab + (size_t)(512 + g * 128) * D + n;
        float acc[4] = {0.f, 0.f, 0.f, 0.f};
#pragma unroll 32
        for (int d = 0; d < 128; ++d) { const float w = wo[(size_t)d * D] * ps[d];
#pragma unroll
            for (int j = 0; j < 4; ++j) acc[j] += pw[j * 128 + d] * w; }
        *(GAS u64*)((bf16*)(ws + WS_WOUT) + (size_t)n * D + 512 + cc) = (u64)pk2(acc[0], acc[1]) | ((u64)pk2(acc[2], acc[3]) << 32);
    }
    {
        f32x4 g4[4];
#pragma unroll
        for (int j = 0; j < 4; ++j) g4[j] = ((const GAS f32x4*)a.norm_mix)[lane + 64 * j];
        for (int m = gw; m < M; m += 4 * NGW) {
            f32x4 v[4][4];
#pragma unroll
            for (int r = 0; r < 4; ++r)
#pragma unroll
                for (int j = 0; j < 4; ++j) v[r][j] = ((const GAS f32x4*)(a.x + (size_t)(m + r * NGW < M ? m + r * NGW : m) * D))[lane + 64 * j];
#pragma unroll
            for (int r = 0; r < 4; ++r) { float sq = 0.f;
#pragma unroll
                for (int j = 0; j < 4; ++j) sq += (v[r][j].x * v[r][j].x + v[r][j].y * v[r][j].y) + (v[r][j].z * v[r][j].z + v[r][j].w * v[r][j].w);
                const float rr = 1.f / sqrtf(wave_sum_dpp(sq) * (1.f / D) + EPS);
                GAS u64* o8 = (GAS u64*)((bf16*)(ws + WS_XN) + (size_t)(m + r * NGW) * D) + lane;
                if (m + r * NGW < M)
#pragma unroll
                for (int j = 0; j < 4; ++j) o8[64 * j] = (u64)pk2(v[r][j].x * rr * g4[j].x, v[r][j].y * rr * g4[j].y) | ((u64)pk2(v[r][j].z * rr * g4[j].z, v[r][j].w * rr * g4[j].w) << 32); }
        }
    }
    for (int m = gw; m < 2 * MROWS; m += NGW) { const int l = m / MROWS, r = m % MROWS; rms_row_to_bf16(lane, a.mem + (size_t)r * D, a.norm_mem + l * D, (bf16*)(ws + WS_MEMN) + (size_t)m * D); }
}
constexpr int RSTD_OFF = LDSCTL_OFF + 1024, RSTD_MAX_UNITS = (LDS_BYTES - RSTD_OFF) / 1024;
__device__ __forceinline__ void fill_rstd(Frame& F, const pg8::StaticOrder& S, const float* ssq) {
    LAS float* tab = (LAS float*)(F.lds + RSTD_OFF); const int tid = otid(F.wave);
    if (tid < 256) {
        for (int i0 = 0; i0 < RSTD_MAX_UNITS; i0 += 4) {
            f32x4 p[4][4]; bool ok[4];
#pragma unroll
            for (int k = 0; k < 4; ++k) { pg8::Unit u; ok[k] = (i0 + k < RSTD_MAX_UNITS) && S.next(i0 + k, u); const int row = ok[k] ? u.pm * 256 + tid : tid;
#pragma unroll
                for (int j = 0; j < 4; ++j) p[k][j] = ((const f32x4*)(ssq + (size_t)row * 16))[j]; }
#pragma unroll
            for (int k = 0; k < 4; ++k) if (ok[k]) { float sm = 0.f;
#pragma unroll
                for (int j = 0; j < 4; ++j) sm += (p[k][j][0] + p[k][j][1]) + (p[k][j][2] + p[k][j][3]);
                tab[(i0 + k) * 256 + tid] = 1.0f / sqrtf(sm * (1.0f / 1024.0f) + EPS); }
            if (!ok[3]) break;
        }
    }
    __syncthreads();
}
__device__ const double ROPE_INV16[16] = { 0.15915494309189535, 0.0700865215877985, 0.03086376340470123, 0.013591370636193905, 0.005985185712713705, 0.002635675898667414, 0.001160663641240061, 0.0005111175045375439,
    0.00022507907903927653, 9.911730936901935e-05, 4.364795279280289e-05, 1.9221100684944863e-05, 8.464330808241401e-06, 3.727408601915352e-06, 1.6414262627950345e-06, 7.228293068832865e-07 };
__device__ __forceinline__ void rope_cs(int t, int d16, float& c, float& s) {
    const double rev = (double)t * ROPE_INV16[d16]; const float f = (float)(rev - __builtin_floor(rev));
    c = __builtin_amdgcn_cosf(f); s = __builtin_amdgcn_sinf(f);
}
struct P2Args { const float *a_q_norm, *a_k_norm, *cross_k_norm; unsigned char* ws; };
__device__ __forceinline__ float row16_sum(float v) {
#define R16_DPP(ctrl) v += __builtin_bit_cast(float, __builtin_amdgcn_update_dpp(0, __builtin_bit_cast(int, v), ctrl, 0xf, 0xf, true))
    R16_DPP(0xB1); R16_DPP(0x4E); R16_DPP(0x141); R16_DPP(0x140);
#undef R16_DPP
    return v;
}
__device__ __forceinline__ float quad_xor2(float v) { return __builtin_bit_cast(float, __builtin_amdgcn_update_dpp(0, __builtin_bit_cast(int, v), 0x4E, 0xf, 0xf, true)); }
__device__ __forceinline__ float quad_xor1(float v) { return __builtin_bit_cast(float, __builtin_amdgcn_update_dpp(0, __builtin_bit_cast(int, v), 0xB1, 0xf, 0xf, true)); }
__device__ __forceinline__ void p2b_rows4(unsigned char* ws, const float* q_norm, const float* k_norm, const int m0, const int lane) {
    const int l16 = lane & 15, e0 = l16 * 8, hq = lane >> 4, t0 = m0 & (T - 1);
    int zo = 0; asm volatile("" : "+s"(zo));
    {
        bf16* qb = (bf16*)(ws + WS_PROJ + (size_t)(0 + (hq >> 1)) * PROJ_T) + (size_t)m0 * 256 + (hq & 1) * 128 + e0;
        bf16* kb = (bf16*)(ws + WS_PROJ + (size_t)(2 + (hq >> 1)) * PROJ_T) + (size_t)m0 * 256 + (hq & 1) * 128 + e0;
        v4u uq[4], uk[4];
#pragma unroll
        for (int r = 0; r < 4; ++r) { uq[r] = *(const v4u*)(qb + r * 256); uk[r] = *(const v4u*)(kb + r * 256); }
        float gq[8], gk[8];
        { const f32x4 a0 = *(const f32x4*)(q_norm + e0), a1 = *(const f32x4*)(q_norm + e0 + 4), b0 = *(const f32x4*)(k_norm + e0), b1 = *(const f32x4*)(k_norm + e0 + 4);
#pragma unroll
          for (int j = 0; j < 4; ++j) { gq[j] = a0[j]; gq[4 + j] = a1[j]; gk[j] = b0[j]; gk[4 + j] = b1[j]; } }
        __builtin_amdgcn_sched_barrier(0);
#pragma unroll
        for (int r = 0; r < 4; ++r) {
            float cs[8], sn[8];
            if (l16 < 4) {
#pragma unroll
                for (int j = 0; j < 8; ++j) rope_cs(t0 + r, (l16 & 1) * 8 + j + zo, cs[j], sn[j]);
            }
#pragma unroll
            for (int it = 0; it < 2; ++it) {
                const v4u u = it ? uk[r] : uq[r]; float x[8] = {bf_lo(u.x), bf_hi(u.x), bf_lo(u.y), bf_hi(u.y), bf_lo(u.z), bf_hi(u.z), bf_lo(u.w), bf_hi(u.w)};
                float ss = 0.f;
#pragma unroll
                for (int j = 0; j < 8; ++j) ss += x[j] * x[j];
                ss = row16_sum(ss);
                const float rr = 1.f / sqrtf(ss * (1.f / 128.f) + EPS);
#pragma unroll
                for (int j = 0; j < 8; ++j) x[j] *= rr * (it ? gk[j] : gq[j]);
                float o[8];
#pragma unroll
                for (int j = 0; j < 8; ++j) o[j] = quad_xor2(x[j]);
                if (l16 < 2) {
#pragma unroll
                    for (int j = 0; j < 8; ++j) x[j] = x[j] * cs[j] - o[j] * sn[j]; }
                else if (l16 < 4) {
#pragma unroll
                    for (int j = 0; j < 8; ++j) x[j] = x[j] * cs[j] + o[j] * sn[j]; }
                *(v4u*)((it ? kb : qb) + r * 256) = (v4u){pk2(x[0], x[1]), pk2(x[2], x[3]), pk2(x[4], x[5]), pk2(x[6], x[7])};
            }
        }
    }
    __builtin_amdgcn_sched_barrier(0);
    {
        const bf16* up = (const bf16*)(ws + WS_PROJ + (size_t)(6 + (hq >> 1)) * PROJ_T) + (size_t)(m0 + 3) * 256 + (hq & 1) * 128 + e0;
        v4u uu[19];
#pragma unroll
        for (int j = 0; j < 19; ++j) uu[j] = *(const v4u*)(up - (ptrdiff_t)((t0 + 3 - j >= 0) ? j : 3) * 256);
        __builtin_amdgcn_sched_barrier(0);
        const int w = 2 << hq;
#pragma unroll
        for (int r = 0; r < 4; ++r) {
            const int cnt = (t0 + r + 1 < w) ? t0 + r + 1 : w; const float ic = 1.f / (float)cnt;
            float acc[8] = {0.f, 0.f, 0.f, 0.f, 0.f, 0.f, 0.f, 0.f}, sf[8];
#pragma unroll
            for (int j = 0; j < 16; ++j) { const v4u u = uu[3 - r + j];
                const float x[8] = {bf_lo(u.x), bf_hi(u.x), bf_lo(u.y), bf_hi(u.y), bf_lo(u.z), bf_hi(u.z), bf_lo(u.w), bf_hi(u.w)};
#pragma unroll
                for (int k = 0; k < 8; ++k) { acc[k] += (j < cnt) ? x[k] : 0.f; if (j == 0) sf[k] = x[k]; } }
            *(v4u*)((bf16*)(ws + WS_XN) + (size_t)(m0 + r) * 1024 + 512 + hq * 128 + e0) = (v4u){pk2(acc[0] * ic - sf[0], acc[1] * ic - sf[1]), pk2(acc[2] * ic - sf[2], acc[3] * ic - sf[3]),
                                                                                               pk2(acc[4] * ic - sf[4], acc[5] * ic - sf[5]), pk2(acc[6] * ic - sf[6], acc[7] * ic - sf[7])}; }
    }
}
__device__ __forceinline__ void p2_post(Frame& F, const P2Args& a) {
    const int gw = blockIdx.x * NWAVES + F.wave, NGW = F.G * NWAVES, lane = otid(F.wave) & 63;
    unsigned char* ws = a.ws;
    for (int m8 = gw; m8 < M / 8; m8 += NGW) {
        const int m = m8 * 8 + (lane >> 3), pc = lane & 7, t = m & (T - 1);
        const v4u u = *(const v4u*)((const bf16*)(ws + WS_PROJ + (size_t)12 * PROJ_T) + (size_t)m * 256 + 16 + pc * 8);
        float x[8] = {bf_lo(u.x), bf_hi(u.x), bf_lo(u.y), bf_hi(u.y), bf_lo(u.z), bf_hi(u.z), bf_lo(u.w), bf_hi(u.w)};
        float o[8];
#pragma unroll
        for (int j = 0; j < 8; ++j) o[j] = quad_xor1(x[j]);
        if (pc < 2) {
#pragma unroll
            for (int j = 0; j < 8; ++j) { float c, sn; rope_cs(t, 2 * j, c, sn); x[j] = pc ? (x[j] * c + o[j] * sn) : (x[j] * c - o[j] * sn); }
        }
        const v4u w = {pk2(x[0], x[1]), pk2(x[2], x[3]), pk2(x[4], x[5]), pk2(x[6], x[7])};
        *(v4u*)(ws + WS_IKT + (((size_t)(m >> 5) * 4 + (pc >> 1)) * 64 + (m & 31) + 32 * (pc & 1)) * 16) = w;
    }
    for (int it = gw; it < 2 * MROWS * 4; it += NGW) {
        const int l = it / (MROWS * 4), r = (it >> 2) % MROWS, h = it & 3;
        u64* p = (u64*)((bf16*)(ws + WS_MKV) + ((size_t)l * MROWS + r) * 2048 + h * 256) + lane;
        const u64 u = *p; float x0 = bf_lo((unsigned)u), x1 = bf_hi((unsigned)u), x2 = bf_lo((unsigned)(u >> 32)), x3 = bf_hi((unsigned)(u >> 32));
        const float rr = 1.f / sqrtf(wave_sum((x0 * x0 + x1 * x1) + (x2 * x2 + x3 * x3)) * (1.f / 256.f) + EPS);
        const f32x4 g = *(const f32x4*)(a.cross_k_norm + l * CHD + 4 * lane);
        *p = (u64)pk2(x0 * rr * g.x, x1 * rr * g.y) | ((u64)pk2(x2 * rr * g.z, x3 * rr * g.w) << 32);
    }
}

namespace d1s {
constexpr int CAP = 576, NE = CAP / 64, SB_BYTES = 4 * CAP * 4, IB_BYTES = 4 * CAP * 2, WAVE_BYTES = SB_BYTES + IB_BYTES + 1024 + 64;
static_assert(NWAVES * WAVE_BYTES <= RING_BYTES, "D1 LDS");
__device__ __forceinline__ unsigned f32_key(float f) { const unsigned u = __float_as_uint(f); return (u & 0x80000000u) ? ~u : (u | 0x80000000u); }
__device__ __forceinline__ float key_f32(unsigned k) { return __uint_as_float((k & 0x80000000u) ? (k ^ 0x80000000u) : ~k); }
__device__ __forceinline__ int mbcnt64(u64 m) { return (int)__builtin_amdgcn_mbcnt_hi((unsigned)(m >> 32), __builtin_amdgcn_mbcnt_lo((unsigned)m, 0u)); }
constexpr int KEEP_MAX = 320;
template <bool EXACT> __device__ __forceinline__ void select256(LAS float* sb, LAS unsigned short* ib, int& cnt, float& th, const int lane) {
    const int n = cnt; if (n <= TOPK) return;
    float v[NE]; unsigned key[NE]; unsigned id[NE];
#pragma unroll
    for (int i = 0; i < NE; ++i) { const int e = lane + 64 * i; v[i] = sb[e]; id[i] = ib[e]; key[i] = (e < n) ? f32_key(v[i]) : 0u; }
    unsigned prefix = 0u; int cur = n;
    for (int bit = 31; bit >= 0; --bit) {
        const unsigned test = prefix | (1u << bit); int c = 0;
#pragma unroll
        for (int i = 0; i < NE; ++i) c += __builtin_popcountll(__ballot(key[i] >= test));
        if (c >= TOPK) { prefix = test; cur = c; }
        if (!EXACT && cur <= KEEP_MAX) break;
    }
    const unsigned tau = prefix; int need = 1 << 30;
    if (EXACT) { int cgt = 0;
#pragma unroll
        for (int i = 0; i < NE; ++i) cgt += __builtin_popcountll(__ballot(key[i] > tau));
        need = TOPK - cgt; }
    int running = 0, ties = 0;
#pragma unroll
    for (int i = 0; i < NE; ++i) {
        bool keep;
        if (EXACT) { const u64 eq = __ballot(key[i] == tau); keep = (key[i] > tau) || (key[i] == tau && ties + mbcnt64(eq) < need); ties += __builtin_popcountll(eq); }
        else keep = key[i] >= tau;
        const u64 kb = __ballot(keep);
        if (keep) { const int pos = running + mbcnt64(kb); sb[pos] = v[i]; ib[pos] = (unsigned short)id[i]; }
        running += __builtin_popcountll(kb);
    }
    cnt = running; th = key_f32(tau);
}
__device__ __forceinline__ float relu1(float x) { const int i = __float_as_int(x); return __int_as_float(i > 0 ? i : 0); }
__device__ __forceinline__ void d1_block(LAS unsigned char* ldsw, const bf16* IQ, const bf16* IKW, const bf16* IKT, u64* BMb, int b, int q0, const int wave, const int lane, const bool pend, const unsigned vnext, volatile LAS unsigned* pslot) {
    const int r32 = lane & 31, hi = lane >> 5;
    LAS float* sbuf = (LAS float*)ldsw; LAS unsigned short* ibuf = (LAS unsigned short*)(ldsw + SB_BYTES); LAS unsigned* bmap = (LAS unsigned*)(ldsw + SB_BYTES + IB_BYTES);
    LAS int* cl = (LAS int*)(ldsw + SB_BYTES + IB_BYTES + 1024); LAS float* tl_ = (LAS float*)(cl + 4);
    const int head = ((r32 >> 3) << 2) + (r32 & 3);
    bf16x8 afr[2][4]; float wq[2][16]; int tl[2];
    const int nkt = (q0 >> 5) + 1;
    const bf16* kp = IKT + ((size_t)(b * T) >> 5) * 2048 + lane * 8;
    bf16x8 bq[4][4];
    v4u wraw[2][2];
#pragma unroll
    for (int rb = 0; rb < 2; ++rb) {
        const int tq = q0 + 4 * wave + 2 * rb + ((r32 >> 2) & 1);
        const bf16* ap = IQ + (size_t)(head >> 2) * ((size_t)M * 256) + (size_t)(b * T + tq) * 256 + (head & 3) * 64 + 8 * hi;
#pragma unroll
        for (int ks = 0; ks < 4; ++ks) afr[rb][ks] = *(const bf16x8*)(ap + ks * 16);
        tl[rb] = q0 + 4 * wave + 2 * rb + hi;
        const bf16* wp = IKW + (size_t)(b * T + tl[rb]) * 256;
        wraw[rb][0] = *(const v4u*)wp; wraw[rb][1] = *(const v4u*)(wp + 8);
    }
#pragma unroll
    for (int u = 0; u < 3; ++u) { const int k = u < nkt ? u : nkt - 1;
#pragma unroll
        for (int ks = 0; ks < 4; ++ks) bq[u][ks] = *(const bf16x8*)(kp + (size_t)k * 2048 + ks * 512); }
    __builtin_amdgcn_sched_barrier(0);
#pragma unroll
    for (int rb = 0; rb < 2; ++rb) {
        const int tq = q0 + 4 * wave + 2 * rb + ((r32 >> 2) & 1);
        {
            float x[8], o[8];
#pragma unroll
            for (int j = 0; j < 8; ++j) x[j] = __uint_as_float(((unsigned)(unsigned short)afr[rb][0][j]) << 16);
#pragma unroll
            for (int j = 0; j < 8; ++j) { const auto rr = __builtin_amdgcn_permlane32_swap(__float_as_uint(x[j]), __float_as_uint(x[j]), false, false); o[j] = __uint_as_float(hi ? rr[0] : rr[1]); }
#pragma unroll
            for (int j = 0; j < 8; ++j) { float c, sn; rope_cs(tq, 2 * j, c, sn); x[j] = hi ? (x[j] * c + o[j] * sn) : (x[j] * c - o[j] * sn); }
            const v4u w = {pk2(x[0], x[1]), pk2(x[2], x[3]), pk2(x[4], x[5]), pk2(x[6], x[7])};
            afr[rb][0] = __builtin_bit_cast(bf16x8, w);
        }
        const v4u w0 = wraw[rb][0], w1 = wraw[rb][1];
        const unsigned ww[8] = {w0.x, w0.y, w0.z, w0.w, w1.x, w1.y, w1.z, w1.w};
#pragma unroll
        for (int j = 0; j < 8; ++j) { wq[rb][2 * j] = bf_lo(ww[j]) * 0.03125f; wq[rb][2 * j + 1] = bf_hi(ww[j]) * 0.03125f; }
    }
    if (pend) { if (lane == 0) *pslot = vnext; }
    int cnt[2][2] = {{0, 0}, {0, 0}}; float thq[2][2] = {{-__builtin_inff(), -__builtin_inff()}, {-__builtin_inff(), -__builtin_inff()}};
    float thv[2] = {-__builtin_inff(), -__builtin_inff()};
    f32x16 accs[2][2];
    accs[0][0] = f32x16{}; accs[0][1] = f32x16{};
#pragma unroll
    for (int ks = 0; ks < 4; ++ks) accs[0][0] = __builtin_amdgcn_mfma_f32_32x32x16_bf16(afr[0][ks], bq[0][ks], accs[0][0], 0, 0, 0);
#pragma unroll
    for (int ks = 0; ks < 4; ++ks) accs[0][1] = __builtin_amdgcn_mfma_f32_32x32x16_bf16(afr[1][ks], bq[0][ks], accs[0][1], 0, 0, 0);
    for (int kt0 = 0; kt0 < nkt; kt0 += 4) {
#pragma unroll
        for (int u = 0; u < 4; ++u) {
            const int kt = kt0 + u; if (kt >= nkt) break;
            { const int k = kt + 3 < nkt ? kt + 3 : nkt - 1;
#pragma unroll
              for (int ks = 0; ks < 4; ++ks) bq[(u + 3) & 3][ks] = *(const bf16x8*)(kp + (size_t)k * 2048 + ks * 512); }
            const int skey = kt * 32 + r32;
            f32x16 accn0 = {}, accn1 = {};
#pragma unroll
            for (int ks = 0; ks < 4; ++ks) accn0 = __builtin_amdgcn_mfma_f32_32x32x16_bf16(afr[0][ks], bq[(u + 1) & 3][ks], accn0, 0, 0, 0);
#pragma unroll
            for (int ks = 0; ks < 4; ++ks) accn1 = __builtin_amdgcn_mfma_f32_32x32x16_bf16(afr[1][ks], bq[(u + 1) & 3][ks], accn1, 0, 0, 0);
            const f32x16 acc0 = accs[u & 1][0], acc1 = accs[u & 1][1];
            accs[(u + 1) & 1][0] = accn0; accs[(u + 1) & 1][1] = accn1;
            float sc[2];
            { float e0 = 0.f, e1 = 0.f;
#pragma unroll
              for (int j = 0; j < 16; ++j) { e0 = __builtin_fmaf(wq[0][j], relu1(acc0[j]), e0); e1 = __builtin_fmaf(wq[1][j], relu1(acc1[j]), e1); }
              sc[0] = e0; sc[1] = e1; }
#pragma unroll
            for (int rb = 0; rb < 2; ++rb) {
                float s = sc[rb];
                if (kt == nkt - 1) { asm volatile("" : "+v"(s)); s = (skey <= q0 + 4 * wave + 2 * rb + hi) ? s : -__builtin_inff(); }
                const bool pass = s > thv[rb];
                const u64 m = __builtin_amdgcn_fcmpf(s, thv[rb], 2  ); const unsigned mlo = (unsigned)m, mhi = (unsigned)(m >> 32);
                const int nlo = __builtin_popcount(mlo);
                const int pos = (int)__builtin_amdgcn_mbcnt_hi(mhi, __builtin_amdgcn_mbcnt_lo(mlo, 0u)) + (hi ? cnt[rb][1] - nlo : cnt[rb][0]);
                if (pass) { const int q = 2 * rb + hi; sbuf[q * CAP + pos] = s; ibuf[q * CAP + pos] = (unsigned short)skey; }
                cnt[rb][0] += nlo; cnt[rb][1] += __builtin_popcount(mhi);
            }
            const int cmax = max(max(cnt[0][0], cnt[0][1]), max(cnt[1][0], cnt[1][1]));
            if (cmax > CAP - 32) {
                if (lane == 0) { cl[0] = cnt[0][0]; cl[1] = cnt[0][1]; cl[2] = cnt[1][0]; cl[3] = cnt[1][1]; tl_[0] = thq[0][0]; tl_[1] = thq[0][1]; tl_[2] = thq[1][0]; tl_[3] = thq[1][1]; }
#pragma unroll 1
                for (int q = 0; q < 4; ++q) { int c = __builtin_amdgcn_readfirstlane(cl[q]);
                    if (c > CAP - 32) { float t_ = 0.f; select256<false>(sbuf + q * CAP, ibuf + q * CAP, c, t_, lane); if (lane == 0) { cl[q] = c; tl_[q] = t_; } } }
                cnt[0][0] = __builtin_amdgcn_readfirstlane(cl[0]); cnt[0][1] = __builtin_amdgcn_readfirstlane(cl[1]); cnt[1][0] = __builtin_amdgcn_readfirstlane(cl[2]); cnt[1][1] = __builtin_amdgcn_readfirstlane(cl[3]);
                thq[0][0] = tl_[0]; thq[0][1] = tl_[1]; thq[1][0] = tl_[2]; thq[1][1] = tl_[3];
                thv[0] = hi ? thq[0][1] : thq[0][0]; thv[1] = hi ? thq[1][1] : thq[1][0];
            }
        }
    }
    if (lane == 0) { cl[0] = cnt[0][0]; cl[1] = cnt[0][1]; cl[2] = cnt[1][0]; cl[3] = cnt[1][1]; }
#pragma unroll 1
    for (int q = 0; q < 4; ++q) {
        int n = __builtin_amdgcn_readfirstlane(cl[q]); float t_ = 0.f;
        select256<true>(sbuf + q * CAP, ibuf + q * CAP, n, t_, lane);
        const int t = q0 + 4 * wave + q;
        { unsigned z_ = 0u; asm volatile("" : "+v"(z_)); *(LAS v4u*)(bmap + 4 * lane) = (v4u){z_, z_, z_, z_}; }
#pragma unroll
        for (int i = 0; i < 4; ++i) { const int e = lane + 64 * i; if (e < n) { const unsigned id = ibuf[q * CAP + e]; __hip_atomic_fetch_or(bmap + (id >> 5), 1u << (id & 31), __ATOMIC_RELAXED, __HIP_MEMORY_SCOPE_WORKGROUP); } }
        const u64 w0 = *(LAS u64*)(bmap + 2 * lane), w1 = *(LAS u64*)(bmap + 128 + 2 * lane);
        BMb[(size_t)lane * T + t] = w0; BMb[(size_t)(64 + lane) * T + t] = w1;
    }
    {
        const float* const volatile __attribute__((address_space(4)))* kin_ = (const float* const volatile __attribute__((address_space(4)))*)__builtin_amdgcn_kernarg_segment_ptr();
        p2b_rows4((unsigned char*)kin_[29], kin_[7], kin_[8], b * T + q0 + 4 * wave, otid(wave) & 63); }
}
constexpr int D1_SLOTS = 128;
__device__ __forceinline__ void d1_phase(Frame& F, unsigned char* ws) {
    const bf16* IQ = (const bf16*)(ws + WS_PROJ + 8 * PROJ_T); const bf16* IKW = (const bf16*)(ws + WS_PROJ + 12 * PROJ_T);
    const int lane = otid(F.wave) & 63;
    LAS unsigned char* ldsw = F.lds + RING_OFF + F.wave * WAVE_BYTES;
    volatile LAS unsigned* tk = F.MISC + 32;
    unsigned* ctr = (unsigned*)(F.ctl + CW_D1Q);
    const unsigned NB = BATCH * 256;
    for (int k = 0; k < D1_SLOTS - 1; ++k) {
        unsigned t = blockIdx.x;
        if (k > 0) {
            unsigned v = 2u + NB;
            if (lane == 0) { v = tk[k]; while (v < 2u) { __builtin_amdgcn_s_sleep(2); v = tk[k]; } }
            t = (unsigned)__builtin_amdgcn_readfirstlane((int)v) - 2u;
        }
        if (t >= NB) break;
        bool pend = false; unsigned vnext = 0u;
        if (lane == 0) { unsigned expect = 0u;
            if (tk[k + 1] == 0u && __hip_atomic_compare_exchange_strong((LAS unsigned*)(tk + k + 1), &expect, 1u, __ATOMIC_RELAXED, __ATOMIC_RELAXED, __HIP_MEMORY_SCOPE_WORKGROUP)) {
                vnext = __hip_atomic_fetch_add(ctr, 1u, __ATOMIC_RELAXED, __HIP_MEMORY_SCOPE_AGENT) + F.G + 2u; pend = true; } }
        const int b = t & 3, p = 255 - (int)(t >> 2); u64* BMb = (u64*)(ws + WS_BM) + (size_t)b * 128 * T;
        if (((((k + 1) >> 1) ^ (F.wave >> 2) ^ 1) & 1)) __builtin_amdgcn_s_setprio(1); else __builtin_amdgcn_s_setprio(0);
        d1_block(ldsw, IQ, IKW, (const bf16*)(ws + WS_IKT), BMb, b, 32 * p, F.wave, otid(F.wave) & 63  , pend, vnext, tk + k + 1);
    }
    __builtin_amdgcn_s_setprio(0);
}
}
namespace xat {
using namespace dsa2;
#define XK(row, colB) ((row) * 512 + ((colB) ^ (((row) & 7) << 4)))
constexpr int XSCR = RING_BYTES + 1024;
__device__ __forceinline__ void cross_unit(const bf16* CQ, const bf16* MKVl, const float* qgain, bf16* CO, int b, int h, int qb, char* lds, const int wave_) {
    const int tid = otid(wave_);
    const int wid = wave_, lane = tid & 63, r32 = lane & 31, hi = lane >> 5;
    float* wsx = (float*)(lds + XSCR) + wid * 64; float* li_l = wsx, * al_l = wsx + 32;
    const size_t row = (size_t)b * ::T + qb * 256 + wid * 32 + r32;
    const bf16* Kg = MKVl + (size_t)(b * MEML) * 2048 + h * CHD; const bf16* Vg = Kg + 1024;
    constexpr float XSCALE = 0.0625f;
    LAS unsigned char* ldsL = (LAS unsigned char*)(LAS char*)lds;
    unsigned koff[4], voff[2];
#pragma unroll
    for (int j = 0; j < 4; ++j) { const int p = wid + 8 * j, kr = 2 * p + (lane >> 5), cc = (lane & 31) ^ (kr & 7); koff[j] = (unsigned)(kr * 2048 + cc * 8); }
#pragma unroll
    for (int j = 0; j < 2; ++j) { const int p = wid + 8 * j, sub = 2 * p + (lane >> 5), kk = (sub >> 2) * 8 + ((lane & 31) >> 2), k = (kk & ~0xC) | ((kk & 4) << 1) | ((kk & 8) >> 1), c = (sub & 3) * 32 + (lane & 3) * 8; voff[j] = (unsigned)(k * 2048 + c); }
#define X_DMAK(t) do { _Pragma("unroll") for (int j_ = 0; j_ < 4; ++j_) __builtin_amdgcn_global_load_lds((const unsigned*)(Kg + (size_t)(t) * 64 * 2048 + koff[j_]), (LAS unsigned*)(ldsL + (t) * 32768 + (wid + 8 * j_) * 1024), 16, 0, 0); } while (0)
#define X_DMAV(t) do { _Pragma("unroll") for (int hf_ = 0; hf_ < 2; ++hf_) _Pragma("unroll") for (int j_ = 0; j_ < 2; ++j_) \
        __builtin_amdgcn_global_load_lds((const unsigned*)(Vg + (size_t)(t) * 64 * 2048 + hf_ * 128 + voff[j_]), (LAS unsigned*)(ldsL + (t) * 32768 + hf_ * 16384 + (wid + 8 * j_) * 1024), 16, 0, 0); } while (0)
#define X_WAIT(n) do { asm volatile("s_waitcnt vmcnt(" #n ")" ::: "memory"); __syncthreads(); } while (0)
    bf16x8 qr[16]; float ss = 0.f;
    const bf16* qp = CQ + row * ::D + h * CHD + 8 * hi;
#pragma unroll
    for (int d0 = 0; d0 < 16; ++d0) qr[d0] = *(const bf16x8*)(qp + d0 * 16);
    __syncthreads();
    X_DMAK(0); X_DMAK(1); X_DMAK(2); X_DMAK(3);
#pragma unroll
    for (int d0 = 0; d0 < 16; ++d0) {
#pragma unroll
        for (int j = 0; j < 8; ++j) { const float x = __uint_as_float(((unsigned)(unsigned short)qr[d0][j]) << 16); ss += x * x; } }
    ss += __shfl_xor(ss, 32);
    const float rn = 1.f / sqrtf(ss * (1.f / 256.f) + EPS);
    const float* qgl = (const float*)(lds + XSCR + 2048);
#pragma unroll
    for (int d0 = 0; d0 < 16; ++d0) { const f32x4 g0 = *(const f32x4*)(qgl + d0 * 16 + 8 * hi), g1 = *(const f32x4*)(qgl + d0 * 16 + 8 * hi + 4);
        f32x4 a, c;
#pragma unroll
        for (int j = 0; j < 4; ++j) { a[j] = __uint_as_float(((unsigned)(unsigned short)qr[d0][j]) << 16) * rn * g0[j]; c[j] = __uint_as_float(((unsigned)(unsigned short)qr[d0][4 + j]) << 16) * rn * g1[j]; }
        qr[d0] = pack8(a, c); }
    const int vb0 = (int)(uintptr_t)lds + v_rd_base(lane);
    float m_reg = -1e30f, l_reg = 0.f;
    float alq[4]; bf16x8 pall[16];
    X_WAIT(12);
#define X_STEPA(t) do { \
        if ((t) > 0) X_DMAV((t) - 1);                        \
        f32x16 p0 = {}, p1 = {}; \
        const char* kb[4]; \
        _Pragma("unroll") for (int dd = 0; dd < 4; ++dd) kb[dd] = lds + (t) * 32768 + XK(r32, dd * 32 + hi * 16); \
        _Pragma("unroll") for (int d0 = 0; d0 < 16; ++d0) { const char* ka = kb[d0 & 3] + (d0 >> 2) * 128; \
            const bf16x8 k0 = *(const bf16x8*)ka; const bf16x8 k1 = *(const bf16x8*)(ka + 32 * 512); \
            p0 = __builtin_amdgcn_mfma_f32_32x32x16_bf16(k0, qr[d0], p0, 0, 0, 0); p1 = __builtin_amdgcn_mfma_f32_32x32x16_bf16(k1, qr[d0], p1, 0, 0, 0); } \
        float mn, alpha; \
        partialSM_s(p0, p1, m_reg, mn, alpha, XSCALE); finishSM(p0, p1, alpha, l_reg, pall[4 * (t)], pall[4 * (t) + 1], pall[4 * (t) + 2], pall[4 * (t) + 3]); \
        alq[t] = alpha; \
        if ((t) == 3) { if (hi == 0) li_l[r32] = l_reg; } \
        X_WAIT(8); } while (0)
    X_STEPA(0); X_STEPA(1); X_STEPA(2); X_STEPA(3);
    f32x16 o[8];
#pragma unroll
    for (int d_ = 0; d_ < 8; ++d_) o[d_] = f32x16{};
#define X_RESC(alpha) do { if (__any((alpha) < 1.f)) { if (hi == 0) al_l[r32] = (alpha); asm volatile("s_waitcnt lgkmcnt(0)" ::: "memory"); \
            _Pragma("unroll") for (int d_ = 0; d_ < 8; ++d_) _Pragma("unroll") for (int r = 0; r < 16; ++r) o[d_][r] *= al_l[crow(r, hi)]; } } while (0)
#define X_STEPB(t, NW) do { \
        if ((t) == 0) X_DMAV(3);                              \
        else X_RESC(alq[t]); \
        pv_tile<0, false>(o, vb0 + (t) * 32768, pall[4 * (t)], pall[4 * (t) + 1], pall[4 * (t) + 2], pall[4 * (t) + 3], true); \
        pv_tile<0, false>(o + 4, vb0 + (t) * 32768 + 16384, pall[4 * (t)], pall[4 * (t) + 1], pall[4 * (t) + 2], pall[4 * (t) + 3], true); \
        if ((t) < 3) X_WAIT(NW); } while (0)
    X_STEPB(0, 8); X_STEPB(1, 4); X_STEPB(2, 0); X_STEPB(3, 0);
    asm volatile("s_waitcnt lgkmcnt(0)" ::: "memory");
    { bf16* Ow = CO + ((size_t)b * ::T + qb * 256 + wid * 32) * ::D + h * CHD;
#pragma unroll
      for (int r = 0; r < 16; ++r) { const int orow = crow(r, hi); const float rl = __builtin_amdgcn_rcpf(li_l[orow]);
#pragma unroll
          for (int d0 = 0; d0 < 8; ++d0) { const float v = o[d0][r] * rl; const float vn = __shfl_xor(v, 1);
              if ((r32 & 1) == 0) *(unsigned*)(Ow + (size_t)orow * ::D + d0 * 32 + r32) = cvtpk(v, vn); } } }
#undef X_STEPA
#undef X_STEPB
#undef X_RESC
#undef X_WAIT
#undef X_DMAK
#undef X_DMAV
}
#undef XK
__device__ __forceinline__ void cross_phase(Frame& F, char* lds, const bf16* CQ, const bf16* MKVl, const float* qgain, bf16* CO, const int rev, unsigned char* ws) {
    { const int t_ = otid(F.wave); if (t_ < CHD) ((float*)(lds + XSCR + 2048))[t_] = qgain[t_]; }
    __syncthreads();
    if (F.G == 256) {
        const int c = obid(), x = c & 7, r = c >> 3;
        for (int k = 0; k < 2; ++k) { const int j = r + 32 * (k ^ rev), panel = 16 * x + (j >> 2), h = j & 3;
            cross_unit(CQ, MKVl, qgain, CO, panel >> 5, h, panel & 31, lds, F.wave); }
    } else {
        for (int u = blockIdx.x; u < BATCH * 4 * (::T / 256); u += F.G) {
            const int qb = u & 31, h = (u >> 5) & 3, b = u >> 7;
            cross_unit(CQ, MKVl, qgain, CO, b, h, qb, lds, F.wave);
        }
    }
}
}

namespace dsa2 {
typedef unsigned short TI;
__device__ __forceinline__ BlockRef<TI, TI> d2_ref(unsigned char* ws, int bh, int qb) {
    const int b = bh >> 2, h = bh & 3; BlockRef<TI, TI> r;
    const size_t rowq = (size_t)b * ::T + (size_t)qb * QB, rowk = (size_t)b * ::T;
    r.Q = (const TI*)(ws + WS_PROJ + (size_t)(0 + (h >> 1)) * PROJ_T) + rowq * LDQ + (h & 1) * 128;
    r.K = (const TI*)(ws + WS_PROJ + (size_t)(2 + (h >> 1)) * PROJ_T) + rowk * LDQ + (h & 1) * 128;
    r.V = (const TI*)(ws + WS_PROJ + (size_t)(4 + (h >> 1)) * PROJ_T) + rowk * LDQ + (h & 1) * 128;
    r.O = (TI*)(ws + WS_XN) + rowq * LDO + h * 128;
    r.MW = (const unsigned long long*)(ws + WS_BM) + (size_t)b * 128 * ::T;
    r.P0 = qb * QB; return r;
}
__device__ __forceinline__ void d2_phase(char* lds, unsigned char* ws, int G, const int wave_) {
    constexpr int nqb = ::T / QB, nx = nqb / 2, total = nx * BATCH * 4;
    int L = blockIdx.x; if (L >= total) return;
    int bh = L / nx, x = L % nx, pass = 0;
    BlockRef<TI, TI> cur = d2_ref(ws, bh, x);
    Seam<TI> S;
    causal_swa_prime<TI, TI>(cur, ::T, lds, S, wave_);
    for (;;) {
        const bool more_pass = pass == 0, more_item = L + G < total, last = !more_pass && !more_item;
        int Ln = L, passn = pass + 1, bhn = bh, xn = x;
        if (!more_pass) { passn = 0; Ln = more_item ? L + G : L; bhn = Ln / nx; xn = Ln % nx; }
        const BlockRef<TI, TI> nxt = last ? cur : d2_ref(ws, bhn, passn ? nqb - 1 - xn : xn);
        causal_swa_block<TI, TI>(cur, nxt, ::T, ::T, lds, S, wave_);
        if (last) break;
        cur = nxt; L = Ln; pass = passn; bh = bhn; x = xn;
    }
}
}

__device__ __forceinline__ void conv_phase(Frame& F, char* lds, const bf16* Gin, const float* dw_w, const float* dw_b, const float* ln_g, const float* ln_b, bf16* OUT) {
    const int tid = otid(F.wave);
    const int lane = tid & 63, wave = F.wave;
    pg8::f32x2 wv[CW];
#pragma unroll
    for (int j = 0; j < CW; ++j) { const float2 v = *(const float2*)(dw_w + j * D + 2 * tid); wv[j] = (pg8::f32x2){v.x, v.y}; }
#pragma unroll
    for (int j = 0; j < CW; ++j) asm volatile("" : "+v"(wv[j]));
    const float2 bias = *(const float2*)(dw_b + 2 * tid), lg = *(const float2*)(ln_g + 2 * tid), lb = *(const float2*)(ln_b + 2 * tid);
    float* red = (float*)lds; float* stat = red + 512;
    const GAS unsigned* G32 = (const GAS unsigned*)Gin; GAS unsigned* O32 = (GAS unsigned*)OUT;
    const int cvb = obid(), cv0 = F.G == 256 ? 128 * (cvb & 7) + (cvb >> 3) : cvb, cvs = F.G == 256 ? 32 : F.G, cvn = F.G == 256 ? 128 * (cvb & 7) + 128 : M / 32;
    for (int tile = cv0; tile < cvn; tile += cvs) {
        const int row0 = tile * 32, t0 = row0 & (T - 1);
        pg8::f32x2 av[32];
#pragma unroll
        for (int r = 0; r < 32; ++r) av[r] = (pg8::f32x2){bias.x, bias.y};
        const GAS unsigned* gp = G32 + ((ptrdiff_t)row0 - (CW - 1)) * 512 + tid;
        constexpr int CPF = 16;
        unsigned ring[CPF];
#pragma unroll
        for (int k = 0; k < CPF; ++k) {
            asm volatile("" : "+v"(gp));
            const bool ok = (t0 - (CW - 1) + k >= 0);
            const GAS unsigned* gcur = ok ? gp : (G32 + tid); gp += 512; ring[k] = *gcur; }
        __builtin_amdgcn_sched_barrier(0);
#pragma unroll
        for (int i = -(CW - 1); i < 32; ++i) {
            unsigned u = ring[(i + CW - 1) % CPF]; u = (t0 + i >= 0) ? u : 0u; const pg8::f32x2 xv = {bf_lo(u), bf_hi(u)};
            if (i + CPF < 32) {
                asm volatile("" : "+v"(gp));
                const bool ok = (t0 + i + CPF >= 0);
                const GAS unsigned* gcur = ok ? gp : (G32 + tid); gp += 512; ring[(i + CW - 1) % CPF] = *gcur; }
#pragma unroll
            for (int r = (i < 0 ? 0 : i); r <= (i + CW - 1 > 31 ? 31 : i + CW - 1); ++r) av[r] = __builtin_elementwise_fma(wv[i + CW - 1 - r], xv, av[r]);
        }
#pragma unroll
        for (int r = 0; r < 32; ++r) { const float s = wave_sum_dpp(av[r].x + av[r].y), q = wave_sum_dpp(av[r].x * av[r].x + av[r].y * av[r].y); if (lane == 0) { red[(r * 8 + wave) * 2] = s; red[(r * 8 + wave) * 2 + 1] = q; } }
        __syncthreads();
        if (tid < 32) { float s = 0.f, q = 0.f;
#pragma unroll
            for (int k = 0; k < 8; ++k) { s += red[(tid * 8 + k) * 2]; q += red[(tid * 8 + k) * 2 + 1]; }
            const float mean = s * (1.f / D), var = fmaxf(q * (1.f / D) - mean * mean, 0.f);
            stat[2 * tid] = mean; stat[2 * tid + 1] = 1.f / sqrtf(var + EPS); }
        __syncthreads();
#pragma unroll
        for (int r = 0; r < 32; ++r) { const float mean = stat[2 * r], rstd = stat[2 * r + 1];
            float y0 = (av[r].x - mean) * rstd * lg.x + lb.x, y1 = (av[r].y - mean) * rstd * lg.y + lb.y;
            y0 = y0 * __builtin_amdgcn_rcpf(1.f + __builtin_amdgcn_exp2f(-1.4426950408889634f * y0)); y1 = y1 * __builtin_amdgcn_rcpf(1.f + __builtin_amdgcn_exp2f(-1.4426950408889634f * y1));
            O32[(size_t)(row0 + r) * 512 + tid] = pk2(y0, y1); }
        __syncthreads();
    }
}

constexpr int NPHASE = 28;
struct Args { const float* in[28]; float* out; unsigned char* ws; int ph_lo, ph_hi; };
__device__ __forceinline__ int osel(int l, int v0, int v1) { int r = __builtin_amdgcn_readfirstlane(v0 + l * (v1 - v0)); asm volatile("" : "+s"(r)); return r; }
template <int LO, int HI> __global__ void __launch_bounds__(NWAVES * 64, 2) trunk_fwd(Args args) {
    extern __shared__ __attribute__((aligned(16))) unsigned char lds[];
    Frame F;
    F.lds = (LAS unsigned char*)lds;
    F.MISC = (volatile LAS unsigned*)(F.lds + MISC_OFF);
    F.wave = __builtin_amdgcn_readfirstlane(threadIdx.x >> 6); F.tid = 0; F.lane = 0;
    F.G = gridDim.x;
    unsigned char* ws = args.ws;
    F.ctl = (gu32*)(ws + WS_CTL);
    for (int u = otid(F.wave); u < (LDS_BYTES - LDSCTL_OFF) / 4; u += NWAVES * 64) ((LAS unsigned*)(F.lds + LDSCTL_OFF))[u] = 0u;
    __syncthreads();
    XcdBarrier bar; bar.wave = F.wave; bar.bar = (unsigned*)(F.ctl + CW_BAR); bar.x = 0; bar.st = nullptr;
    if (!MK_PER_PHASE) { bar = xcd_barrier_post((unsigned*)(F.ctl + CW_BAR), F.MISC + 8, F.wave);
        if (F.wave == 0 && lane_id_() == 0 && (bar.x != (unsigned)(blockIdx.x & 7) || gridDim.x != 256u)) (void)xb_add((unsigned*)(F.ctl + CW_MIS), 1u); }
    constexpr int lo = LO, hi = HI;
#ifdef ONLY_PHASE
#define IN(k) (((k) == ONLY_PHASE || ((k) >= 17 && (k) - 11 == ONLY_PHASE)) && lo <= (k) && (k) < hi)
#else
#define IN(k) (lo <= (k) && (k) < hi)
#endif
#define SEAM(k) do { if (!MK_PER_PHASE && (k) + 1 < hi) xcd_barrier(bar); } while (0)
#define SEAM_L(k) do { if (!MK_PER_PHASE && (k) + 1 < hi) { if (F.MISC[10]) xcd_barrier_local(bar); else xcd_barrier(bar); } } while (0)
    const float* const volatile __attribute__((address_space(4)))* kin = (const float* const volatile __attribute__((address_space(4)))*)__builtin_amdgcn_kernarg_segment_ptr();
#define INP(i) (kin[i])
    float* H = args.out;
    bf16* XN = (bf16*)(ws + WS_XN);

    if (IN(0)) {
        P0Args a{INP(3), INP(5), INP(0), INP(1), INP(2), INP(4), INP(6), INP(9), INP(10), INP(11), INP(12), INP(18), INP(19), INP(20), INP(21), INP(24), INP(25), INP(26), INP(27), ws};
        p0_prologue(F, a); SEAM(0);
        if (!MK_PER_PHASE) {
            if (F.wave == 0 && lane_id_() == 0) F.MISC[10] = (xb_ld((unsigned*)(F.ctl + CW_MIS)) == 0u) ? 1u : 0u;
            __syncthreads(); }
    }
    if (IN(1)) {
        { pg8::Gemm g{XN, (const bf16*)(ws + WS_WIN), M, NINP, D}; pg8::StaticOrder S; S.init(M, NINP, F.G, obid());
          pg8::EpiBf16<0, false, true> E{(bf16*)(ws + WS_PROJ), 256, nullptr, 256, (size_t)M * 256, 1.f, nullptr};
          pg8::gemm_phase<pg8::EpiBf16<0, false, true>, pg8::StaticOrder, true, true>(F.lds + RING_OFF, g, S, E, F.wave); }
        for (int l = 0; l < 2; ++l) {
          pg8::Gemm g{(const bf16*)(ws + WS_MEMN) + (size_t)l * MROWS * D, (const bf16*)(ws + WS_WCKV) + (size_t)l * 2 * D * D, MROWS, 2 * D, D}; pg8::StaticOrder S; S.init(MROWS, 2 * D, F.G, (int)((blockIdx.x + 128 - 32 * l) % F.G));
          pg8::EpiBf16<0, false, true> E{(bf16*)(ws + WS_MKV) + (size_t)l * MROWS * 2 * D, 2 * D, nullptr, 0, 0, 1.f, nullptr};
          pg8::gemm_phase<pg8::EpiBf16<0, false, true>, pg8::StaticOrder, true, true>(F.lds + RING_OFF, g, S, E, F.wave); }
        SEAM(1);
    }
    if (IN(2)) { P2Args a{INP(7), INP(8), INP(23), ws}; p2_post(F, a); SEAM(2); }
    if (IN(3)) { d1s::d1_phase(F, ws); SEAM(3); }
    if (IN(4)) { dsa2::d2_phase((char*)lds + RING_OFF, ws, F.G, F.wave); SEAM(4); }
    bf16* HB2 = (bf16*)(ws + WS_HB2);
    bf16* CQb = (bf16*)H; bf16* COb = CQb + (size_t)M * D;
    if (IN(5)) {
        pg8::Gemm g{XN, (const bf16*)(ws + WS_WOUT), M, D, D}; pg8::StaticOrder S; S.init(M, D, F.G, obid());
        pg8::EpiRes2<true> E{INP(0), nullptr, HB2, (float*)(ws + WS_SSQ), D};
        pg8::gemm_phase<pg8::EpiRes2<true>, pg8::StaticOrder, true, true>(F.lds + RING_OFF, g, S, E, F.wave); SEAM_L(5);
    }
#if MK_PER_PHASE
#pragma unroll
#else
#pragma unroll 1
#endif
    for (int l_it = 0; l_it < 2; ++l_it) {
        int l = l_it; asm volatile("" : "+s"(l));
        const int pb = 6 + 11 * l_it;
        float* ssq_cq = (float*)(ws + WS_SSQ + (size_t)(3 * l) * SSQ_BYTES); float* ssq_ffn = (float*)(ws + WS_SSQ + (size_t)(3 * l + 1) * SSQ_BYTES); float* ssq_dn = (float*)(ws + WS_SSQ + 2 * SSQ_BYTES);
        if (l == 1) {
            if (IN(pb + 1)) {
                pg8::Gemm g{HB2, (const bf16*)(ws + WS_WCIN), M, 2 * D, D}; pg8::StaticOrder S; S.init(M, 2 * D, F.G, obid());
                fill_rstd(F, S, ssq_dn);
                pg8::EpiGate<1> E{COb, D, INP(13), D, (const LAS float*)(F.lds + RSTD_OFF)};
                pg8::gemm_phase<pg8::EpiGate<1>, pg8::StaticOrder, true, true>(F.lds + RING_OFF, g, S, E, F.wave); SEAM(pb + 1);
            }
            if (IN(pb + 2)) { conv_phase(F, (char*)lds + RING_OFF, COb, INP(14), INP(15), INP(16), INP(17), XN); SEAM(pb + 2); }
            if (IN(pb + 3)) {
                pg8::Gemm g{XN, (const bf16*)(ws + WS_WCOUT), M, D, D}; pg8::StaticOrder S; S.init(M, D, F.G, obid(), 1);
                pg8::EpiRes2<false> E{HB2, nullptr, HB2, ssq_cq, D};
                pg8::gemm_phase<pg8::EpiRes2<false>, pg8::StaticOrder, true, true>(F.lds + RING_OFF, g, S, E, F.wave); SEAM_L(pb + 3);
            }
        }
        if (IN(pb + 5)) {
            pg8::Gemm g{HB2, (const bf16*)(ws + WS_WCQ) + (size_t)l * D * D, M, D, D}; pg8::StaticOrder S; S.init(M, D, F.G, obid(), osel(l, 1, 0));
            pg8::EpiBf16<0> E{CQb, D, nullptr, 0, 0, 1.f, nullptr};
            pg8::gemm_phase<pg8::EpiBf16<0>, pg8::StaticOrder, true, true>(F.lds + RING_OFF, g, S, E, F.wave); SEAM_L(pb + 5);
        }
        if (IN(pb + 6)) { xat::cross_phase(F, (char*)lds + RING_OFF, CQb, (const bf16*)(ws + WS_MKV) + (size_t)l * MROWS * 2 * D, INP(22) + l * CHD, COb, osel(l, 0, 1), ws); SEAM_L(pb + 6); }
        if (IN(pb + 7)) {
            pg8::Gemm g{COb, (const bf16*)(ws + WS_WCO) + (size_t)l * D * D, M, D, D}; pg8::StaticOrder S; S.init(M, D, F.G, obid(), osel(l, 1, 0));
            pg8::EpiRes2<false> E{HB2, nullptr, XN, ssq_ffn, D};
            pg8::gemm_phase<pg8::EpiRes2<false>, pg8::StaticOrder, true, true>(F.lds + RING_OFF, g, S, E, F.wave); SEAM_L(pb + 7);
        }
        if (IN(pb + 9)) {
            pg8::Gemm g{XN, (const bf16*)(ws + WS_WGU) + (size_t)l * 2 * DFF * D, M, 2 * DFF, D}; pg8::StaticOrder S; S.init(M, 2 * DFF, F.G, obid(), osel(l, 0, 1));
            fill_rstd(F, S, ssq_ffn);
            pg8::EpiGate<0> E{(bf16*)(ws + WS_HID), DFF, nullptr, 0, (const LAS float*)(F.lds + RSTD_OFF)};
            pg8::gemm_phase<pg8::EpiGate<0>, pg8::StaticOrder, true, true>(F.lds + RING_OFF, g, S, E, F.wave); if (l == 0) SEAM_L(pb + 9); else SEAM(pb + 9);
        }
        if (IN(pb + 10)) {
            pg8::Gemm g{(const bf16*)(ws + WS_HID), (const bf16*)(ws + WS_WDN) + (size_t)l * D * DFF, M, D, DFF}; pg8::StaticOrder S; S.init(M, D, F.G, obid(), osel(l, 1, 0));
            pg8::EpiRes2<false> E{XN, l ? H : nullptr, HB2, ssq_dn, D};
            pg8::gemm_phase<pg8::EpiRes2<false>, pg8::StaticOrder, true, true>(F.lds + RING_OFF, g, S, E, F.wave); SEAM_L(pb + 10);
        }
    }
#undef IN
#undef SEAM
}

extern "C" void kernel_launch(void* const* d_in, const int* in_sizes, int n_in, void* d_out, int out_size, void* d_ws, size_t ws_size, hipStream_t stream) {
    static int grid = 0;
    if (grid == 0) {
        if (n_in != 28 || in_sizes[0] != M * D || out_size != M * D || ws_size < WS_END) { fprintf(stderr, "kernel_launch: unexpected shapes (n_in %d, in0 %d, out %d, ws %zu)\n", n_in, n_in > 0 ? in_sizes[0] : -1, out_size, ws_size); grid = -1; return; }
        int dev = 0, cus = 0, per_cu = 0;
        if (hipGetDevice(&dev) != hipSuccess || hipDeviceGetAttribute(&cus, hipDeviceAttributeMultiprocessorCount, dev) != hipSuccess) { grid = -1; return; }
#if !MK_PER_PHASE
        if (hipFuncSetAttribute((const void*)trunk_fwd<0, NPHASE>, hipFuncAttributeMaxDynamicSharedMemorySize, LDS_BYTES) != hipSuccess) { fprintf(stderr, "kernel_launch: hipFuncSetAttribute failed\n"); grid = -1; return; }
        if (hipOccupancyMaxActiveBlocksPerMultiprocessor(&per_cu, (const void*)trunk_fwd<0, NPHASE>, NWAVES * 64, LDS_BYTES) != hipSuccess || per_cu < 1) fprintf(stderr, "kernel_launch: note: occupancy query reports %d workgroups per CU\n", per_cu);
#endif
        (void)hipGetLastError();
        grid = cus > 256 ? 256 : cus;
    }
    if (grid < 0) return;
    if (hipMemsetAsync((char*)d_ws + WS_CTL, 0, CTL_ZERO_BYTES, stream) != hipSuccess) return;
    Args a{};
    for (int i = 0; i < 28; ++i) a.in[i] = (const float*)d_in[i];
    a.out = (float*)d_out; a.ws = (unsigned char*)d_ws;
#if MK_PER_PHASE
#define LAUNCH_PH(p) do { static bool attr_ = false; if (!attr_) { (void)hipFuncSetAttribute((const void*)trunk_fwd<p, p + 1>, hipFuncAttributeMaxDynamicSharedMemorySize, LDS_BYTES); attr_ = true; } \
        hipLaunchKernelGGL((trunk_fwd<p, p + 1>), dim3(grid), dim3(NWAVES * 64), LDS_BYTES, stream, a); } while (0)
    LAUNCH_PH(0); LAUNCH_PH(1); LAUNCH_PH(2); LAUNCH_PH(3); LAUNCH_PH(4); LAUNCH_PH(5);
    LAUNCH_PH(11); LAUNCH_PH(12); LAUNCH_PH(13); LAUNCH_PH(15); LAUNCH_PH(16);
    LAUNCH_PH(18); LAUNCH_PH(19); LAUNCH_PH(20); LAUNCH_PH(22); LAUNCH_PH(23); LAUNCH_PH(24); LAUNCH_PH(26); LAUNCH_PH(27);
#else
    hipLaunchKernelGGL((trunk_fwd<0, NPHASE>), dim3(grid), dim3(NWAVES * 64), LDS_BYTES, stream, a);
#endif
}
```

```cpp
#include <hip/hip_runtime.h>
#include <cstdio>
#include <cstdint>
__device__ __forceinline__ int obid() { int b = blockIdx.x; asm volatile("" : "+s"(b)); return b; }
__device__ __forceinline__ int lane_id_() { int l; asm volatile("v_mbcnt_lo_u32_b32 %0, -1, 0\n\tv_mbcnt_hi_u32_b32 %0, -1, %0" : "=v"(l)); return l; }
__device__ __forceinline__ int otid(int wave) { return wave * 64 + lane_id_(); }
namespace pg8 {
#define PG8_LAS __attribute__((address_space(3)))
typedef unsigned short bf16_t;
typedef short bf16x8 __attribute__((ext_vector_type(8)));
typedef float f32x4 __attribute__((ext_vector_type(4)));
typedef unsigned u32x4 __attribute__((ext_vector_type(4)));
constexpr int BM = 256, BK = 64, HALF = 128, HTB = HALF * BK * 2  , STAGE_BYTES = 8 * HTB, NXCD = 8, WGM = 4;

__host__ __device__ __forceinline__ int lds_byte(int r, int c) { const int st = (r >> 4) * 2 + (c >> 5), rr = r & 15, cc = c & 31, ob = rr * 64 + cc * 2; return st * 1024 + (ob ^ (((ob >> 9) & 1) << 5)); }
__host__ __device__ __forceinline__ void stage_rc(int b, int& R, int& C) { const int st = b / 1024, sb = b % 1024, swz = sb ^ (((sb >> 9) & 1) << 5); R = (st >> 1) * 16 + swz / 64; C = (st & 1) * 32 + (swz % 64) / 2; }
__host__ __device__ __forceinline__ int perm32(int rho) { const int n = rho >> 4, i = rho & 15; return 8 * (i >> 2) + 4 * n + (i & 3); }

struct Unit { int pm, pn, idx; };
struct Gemm { const bf16_t* A; const bf16_t* Bt; int M, N, K; };

struct StaticOrder {
    int nM, nN, nwg, G, c, rev;
    __host__ __device__ __attribute__((always_inline)) void init(int M, int N, int G_, int c_, int rev_ = 0) { nM = M / BM; nN = N / BM; nwg = nM * nN; G = G_; c = c_; rev = (rev_ && nwg % G_ == 0) ? nwg / G_ : 0; }
    __host__ __device__ bool next(int i, Unit& u) const {
        const long L = (long)(rev ? (i < rev ? rev - 1 - i : i) : i) * G + c; if (L >= nwg) return false;
        int wgid = (int)L; { const int q = nwg / NXCD, r = nwg % NXCD, xcd = wgid % NXCD, off = wgid / NXCD; wgid = (xcd < r ? xcd * (q + 1) : r * (q + 1) + (xcd - r) * q) + off; }
        const int nig = WGM * nN, gid = wgid / nig, fm = gid * WGM, gsz = (nM - fm) < WGM ? (nM - fm) : WGM;
        u.pm = fm + ((wgid % nig) % gsz); u.pn = (wgid % nig) / gsz; u.idx = i; return true;
    }
    __device__ __forceinline__ void a_ready(const Unit&) const {}
    __device__ __forceinline__ void done(const Unit&) const {}
};

__device__ __forceinline__ unsigned cvt_pk_bf16(float lo, float hi) { unsigned r; asm volatile("v_cvt_pk_bf16_f32 %0, %1, %2" : "=v"(r) : "v"(lo), "v"(hi)); return r; }
typedef float f32x2 __attribute__((ext_vector_type(2)));
__device__ __forceinline__ f32x2 gelu_pk(f32x2 v) {
    const f32x2 av = __builtin_elementwise_abs(v), d = av * 0.2316418882f + 1.0f;
    f32x2 t; t.x = __builtin_amdgcn_rcpf(d.x); t.y = __builtin_amdgcn_rcpf(d.y);
    f32x2 q = t * 0.5307027145f + (-0.7265760135f); q = q * t + 0.7107068705f; q = q * t + (-0.142248368f); q = q * t + 0.127414796f; q = q * t;
    const f32x2 s = (v * v) * (-0.72134752044f);
    f32x2 e; e.x = __builtin_amdgcn_exp2f(s.x); e.y = __builtin_amdgcn_exp2f(s.y);
    const f32x2 m = v * (q * e), r = v - m;
    f32x2 o; o.x = v.x < 0.f ? m.x : r.x; o.y = v.y < 0.f ? m.y : r.y; return o;
}

__device__ __forceinline__ float row_rstd(const float* ssq, int row);
__device__ __forceinline__ void store16_wt(void* p, u32x4 v) { asm volatile("global_store_dwordx4 %0, %1, off sc1\n\ts_nop 2" :: "v"(p), "v"(v) : "memory"); }
template <int ACT  , bool RS = false  , bool WT = false> struct EpiBf16 {
    static constexpr bool PERM = true, AFTER_DRAIN = false; static_assert(ACT == 0 || ACT == 1, "EpiBf16: ACT is 0 (none) or 1 (gelu_pk)");
    bf16_t* O; int ldc; const float* bias; int split_cols; size_t split_stride; float scale0; const float* ssq;
    __device__ __forceinline__ void operator()(const f32x4 (&acc)[2][2][4][2], const Unit& u, int wr, int wc, int fr, int fq) const {
        const int row0 = u.pm * BM + wr * 64 + fr; int colt = u.pn * BM; bf16_t* base = O;
        float sc = 1.f; if (split_cols) { const int t = colt / split_cols; base += (size_t)t * split_stride; colt -= t * split_cols; if (t == 0) sc = scale0; }
        const int col0 = colt + wc * 32 + 8 * fq, bcol0 = u.pn * BM + wc * 32 + 8 * fq;
        f32x4 bv[2][2];
#pragma unroll
        for (int bj = 0; bj < 2; ++bj)
#pragma unroll
            for (int n = 0; n < 2; ++n) bv[bj][n] = bias ? *(const f32x4*)(bias + bcol0 + bj * HALF + 4 * n) : (f32x4){0.f, 0.f, 0.f, 0.f};
#pragma unroll
        for (int ai = 0; ai < 2; ++ai)
#pragma unroll
            for (int m = 0; m < 4; ++m) { bf16_t* rowp = base + (size_t)(row0 + ai * HALF + m * 16) * ldc + col0;
                const float rs = RS ? row_rstd(ssq, row0 + ai * HALF + m * 16) : 1.0f;
#pragma unroll
                for (int bj = 0; bj < 2; ++bj) { f32x4 v0 = acc[ai][bj][m][0] * rs + bv[bj][0], v1 = acc[ai][bj][m][1] * rs + bv[bj][1];
                    if (ACT == 1) { f32x2 a = gelu_pk((f32x2){v0[0], v0[1]}), b = gelu_pk((f32x2){v0[2], v0[3]}), c = gelu_pk((f32x2){v1[0], v1[1]}), d = gelu_pk((f32x2){v1[2], v1[3]});
                        v0 = (f32x4){a.x, a.y, b.x, b.y}; v1 = (f32x4){c.x, c.y, d.x, d.y}; }
                    v0 = v0 * sc; v1 = v1 * sc; u32x4 w; w.x = cvt_pk_bf16(v0[0], v0[1]); w.y = cvt_pk_bf16(v0[2], v0[3]); w.z = cvt_pk_bf16(v1[0], v1[1]); w.w = cvt_pk_bf16(v1[2], v1[3]);
                    if (WT) store16_wt(rowp + bj * HALF, w); else *(u32x4*)(rowp + bj * HALF) = w; } }
    }
};

template <bool BASE_F32> struct EpiRes2 {
    static constexpr bool PERM = true, AFTER_DRAIN = false;
    const void* base; float* C; bf16_t* HB; float* ssq; int ldc;
    __device__ __forceinline__ void emit(const f32x4 (&acc)[2][2][4][2], const f32x4 (&bs)[2][2], const Unit& u, int ai, int m, int row, size_t off, int wc, int fq) const {
        float ss = 0.f;
#pragma unroll
        for (int bj = 0; bj < 2; ++bj) { const f32x4 v0 = bs[bj][0] + acc[ai][bj][m][0], v1 = bs[bj][1] + acc[ai][bj][m][1];
            if (C) { *(f32x4*)(C + off + bj * HALF) = v0; *(f32x4*)(C + off + bj * HALF + 4) = v1; }
            else { ss += ((v0[0] * v0[0] + v0[1] * v0[1]) + (v0[2] * v0[2] + v0[3] * v0[3])) + ((v1[0] * v1[0] + v1[1] * v1[1]) + (v1[2] * v1[2] + v1[3] * v1[3]));
                u32x4 w; w.x = cvt_pk_bf16(v0[0], v0[1]); w.y = cvt_pk_bf16(v0[2], v0[3]); w.z = cvt_pk_bf16(v1[0], v1[1]); w.w = cvt_pk_bf16(v1[2], v1[3]);
                *(u32x4*)(HB + off + bj * HALF) = w; } }
        if (!C) { ss += __shfl_xor(ss, 16); ss += __shfl_xor(ss, 32);
            if (fq == 0) ssq[(size_t)row * 16 + u.pn * 4 + wc] = ss; }
    }
    __device__ __forceinline__ void operator()(const f32x4 (&acc)[2][2][4][2], const Unit& u, int wr, int wc, int fr, int fq) const {
        const int row0 = u.pm * BM + wr * 64 + fr, col0 = u.pn * BM + wc * 32 + 8 * fq;
        if constexpr (!BASE_F32) {
            u32x4 bw[8][2];
#pragma unroll
            for (int it = 0; it < 8; ++it) { const bf16_t* p = (const bf16_t*)base + (size_t)(row0 + (it >> 2) * HALF + (it & 3) * 16) * ldc + col0;
                bw[it][0] = *(const u32x4*)p; bw[it][1] = *(const u32x4*)(p + HALF); }
#pragma unroll
            for (int it = 0; it < 8; ++it) { const int ai = it >> 2, m = it & 3, row = row0 + ai * HALF + m * 16; const size_t off = (size_t)row * ldc + col0;
                f32x4 bs[2][2];
#pragma unroll
                for (int bj = 0; bj < 2; ++bj) { const u32x4 w = bw[it][bj];
                    bs[bj][0] = (f32x4){__uint_as_float(w.x << 16), __uint_as_float(w.x & 0xffff0000u), __uint_as_float(w.y << 16), __uint_as_float(w.y & 0xffff0000u)};
                    bs[bj][1] = (f32x4){__uint_as_float(w.z << 16), __uint_as_float(w.z & 0xffff0000u), __uint_as_float(w.w << 16), __uint_as_float(w.w & 0xffff0000u)}; }
                emit(acc, bs, u, ai, m, row, off, wc, fq); }
        } else {
            f32x4 bq[4][2][2];
#pragma unroll
            for (int it = 0; it < 4; ++it) { const float* p = (const float*)base + (size_t)(row0 + it * 16) * ldc + col0;
#pragma unroll
                for (int bj = 0; bj < 2; ++bj) { bq[it][bj][0] = *(const f32x4*)(p + bj * HALF); bq[it][bj][1] = *(const f32x4*)(p + bj * HALF + 4); } }
#pragma unroll
            for (int it = 0; it < 8; ++it) { const int ai = it >> 2, m = it & 3, row = row0 + ai * HALF + m * 16; const size_t off = (size_t)row * ldc + col0;
                emit(acc, bq[it & 3], u, ai, m, row, off, wc, fq);
                if (it < 4) { const float* p = (const float*)base + off + (size_t)HALF * ldc;
#pragma unroll
                    for (int bj = 0; bj < 2; ++bj) { bq[it][bj][0] = *(const f32x4*)(p + bj * HALF); bq[it][bj][1] = *(const f32x4*)(p + bj * HALF + 4); } } }
        }
    }
};
__device__ __forceinline__ float row_rstd(const float* ssq, int row) {
    const f32x4* p = (const f32x4*)(ssq + (size_t)row * 16); const f32x4 a = p[0], b = p[1], c = p[2], d = p[3];
    const float s = ((a[0] + a[1]) + (a[2] + a[3])) + ((b[0] + b[1]) + (b[2] + b[3])) + ((c[0] + c[1]) + (c[2] + c[3])) + ((d[0] + d[1]) + (d[2] + d[3]));
    return 1.0f / sqrtf(s * (1.0f / 1024.0f) + 1e-6f);
}
template <int MODE> struct EpiGate {
    static constexpr bool PERM = true, AFTER_DRAIN = false;
    bf16_t* O; int ldc; const float* bias; int NH; const PG8_LAS float* rstd;
    __device__ __forceinline__ void operator()(const f32x4 (&acc)[2][2][4][2], const Unit& u, int wr, int wc, int fr, int fq) const {
        const int row0 = u.pm * BM + wr * 64 + fr, col0 = u.pn * HALF + wc * 32 + 8 * fq;
        f32x4 bl[2], br[2];
#pragma unroll
        for (int n = 0; n < 2; ++n) { bl[n] = (MODE == 1) ? *(const f32x4*)(bias + col0 + 4 * n) : (f32x4){0.f, 0.f, 0.f, 0.f}; br[n] = (MODE == 1) ? *(const f32x4*)(bias + NH + col0 + 4 * n) : (f32x4){0.f, 0.f, 0.f, 0.f}; }
#pragma unroll
        for (int ai = 0; ai < 2; ++ai)
#pragma unroll
            for (int m = 0; m < 4; ++m) { bf16_t* rowp = O + (size_t)(row0 + ai * HALF + m * 16) * ldc + col0;
                const float rs = rstd[u.idx * BM + wr * 64 + fr + ai * HALF + m * 16];
                f32x4 v[2];
#pragma unroll
                for (int n = 0; n < 2; ++n) { const f32x4 l = acc[ai][0][m][n] * rs + bl[n], r = acc[ai][1][m][n] * rs + br[n];
#pragma unroll
                    for (int j = 0; j < 4; ++j) {
                        if (MODE == 0) { const float s = __builtin_amdgcn_rcpf(1.0f + __builtin_amdgcn_exp2f(-1.4426950408889634f * l[j])); v[n][j] = l[j] * s * r[j]; }
                        else { const float s = __builtin_amdgcn_rcpf(1.0f + __builtin_amdgcn_exp2f(-1.4426950408889634f * r[j])); v[n][j] = l[j] * s; } } }
                u32x4 w; w.x = cvt_pk_bf16(v[0][0], v[0][1]); w.y = cvt_pk_bf16(v[0][2], v[0][3]); w.z = cvt_pk_bf16(v[1][0], v[1][1]); w.w = cvt_pk_bf16(v[1][2], v[1][3]);
                *(u32x4*)rowp = w; }
    }
};

template <class Epi, class Sched, bool ALIGN_EPI = false, bool SP2 = false>
__device__ __forceinline__ void gemm_phase(PG8_LAS unsigned char* lds, const Gemm g, const Sched& S, const Epi& E, const int wave_) {
    const int tid = otid(wave_), wid = wave_, lane = tid & 63, wr = wid >> 2, wc = wid & 3, fr = lane & 15, fq = lane >> 4;
    const int K = g.K, nt = K / BK;
    unsigned voffA[2], voffB[2];
#pragma unroll
    for (int i = 0; i < 2; ++i) { int R, C; stage_rc(tid * 16 + i * 8192, R, C); const int Rb = Epi::PERM ? ((R & ~31) + perm32(R & 31)) : R;
        voffA[i] = (unsigned)(R * K + C) * 2u; voffB[i] = (unsigned)(Rb * K + C) * 2u; }
    const size_t kstep = (size_t)(BK * 2);
    const size_t hstep = (size_t)HALF * K * 2;
    const size_t tstep = 2 * hstep;
    const unsigned ldsw = (unsigned)wid * 1024u;
    const int aoff = lds_byte(wr * 64 + fr, fq * 8), boff = lds_byte(wc * 32 + fr, fq * 8);
#define PG8_SA(b, h) (((b) * 2 + (h)) * HTB)
#define PG8_SB(b, h) ((4 + (b) * 2 + (h)) * HTB)
#define PG8_STAGE(bufoff, gbase, voff) do { _Pragma("unroll") for (int _i = 0; _i < 2; ++_i) \
        __builtin_amdgcn_global_load_lds((const unsigned*)((const char*)(gbase) + (voff)[_i]), (PG8_LAS unsigned*)(lds + (bufoff) + ldsw + _i * 8192), 16, 0, 0); } while (0)
#define PG8_LDA(dst, b, h) do { _Pragma("unroll") for (int m = 0; m < 4; ++m) _Pragma("unroll") for (int k = 0; k < 2; ++k) dst[m][k] = *(const PG8_LAS bf16x8*)(lds + PG8_SA(b, h) + aoff + m * 2048 + k * 1024); } while (0)
#define PG8_LDB(dst, b, h) do { _Pragma("unroll") for (int n = 0; n < 2; ++n) _Pragma("unroll") for (int k = 0; k < 2; ++k) dst[n][k] = *(const PG8_LAS bf16x8*)(lds + PG8_SB(b, h) + boff + n * 2048 + k * 1024); } while (0)
#define PG8_MMA(ai, bj, At, Bt) do { __builtin_amdgcn_s_setprio(1); _Pragma("unroll") for (int m = 0; m < 4; ++m) _Pragma("unroll") for (int n = 0; n < 2; ++n) _Pragma("unroll") for (int k = 0; k < 2; ++k) \
        acc[ai][bj][m][n] = __builtin_amdgcn_mfma_f32_16x16x32_bf16(Bt[n][k], At[m][k], acc[ai][bj][m][n], 0, 0, 0); __builtin_amdgcn_s_setprio(0); } while (0)
#define PG8_WAIT_V(n) asm volatile("s_waitcnt vmcnt(" #n ")" ::: "memory")
#define PG8_WAIT_L(n) asm volatile("s_waitcnt lgkmcnt(" #n ")" ::: "memory")
#define PG8_BAR __builtin_amdgcn_s_barrier()
#define PG8_SCHED __builtin_amdgcn_sched_barrier(0)
    Unit cur, nxt; int ui = 0;
    if (!S.next(0, cur)) return;
    f32x4 acc[2][2][4][2];
#pragma unroll
    for (int a = 0; a < 2; ++a)
#pragma unroll
        for (int b = 0; b < 2; ++b)
#pragma unroll
            for (int m = 0; m < 4; ++m)
#pragma unroll
                for (int n = 0; n < 2; ++n) acc[a][b][m][n] = (f32x4){0.f, 0.f, 0.f, 0.f};
    bf16x8 At[4][2], B0[2][2], B1[2][2];
    const char* cA = (const char*)g.A + (size_t)cur.pm * tstep; const char* cB = (const char*)g.Bt + (size_t)cur.pn * tstep;
    S.a_ready(cur);
    if constexpr (SP2) {
        PG8_STAGE(PG8_SB(0, 0), cB, voffB); PG8_STAGE(PG8_SB(0, 1), cB + hstep, voffB); PG8_STAGE(PG8_SA(0, 0), cA, voffA); PG8_STAGE(PG8_SA(0, 1), cA + hstep, voffA);
        if (wr == 1) PG8_BAR;
        PG8_WAIT_V(2); PG8_BAR;
        PG8_STAGE(PG8_SB(1, 0), cB + kstep, voffB); PG8_STAGE(PG8_SA(1, 0), cA + kstep, voffA); PG8_STAGE(PG8_SB(1, 1), cB + hstep + kstep, voffB);
        PG8_WAIT_V(6); PG8_BAR;
    } else {
        PG8_STAGE(PG8_SB(0, 0), cB, voffB); PG8_STAGE(PG8_SA(0, 0), cA, voffA); PG8_STAGE(PG8_SB(0, 1), cB + hstep, voffB); PG8_STAGE(PG8_SA(0, 1), cA + hstep, voffA);
        if (wr == 1) PG8_BAR;
        PG8_WAIT_V(4); PG8_BAR;
        PG8_STAGE(PG8_SB(1, 0), cB + kstep, voffB); PG8_STAGE(PG8_SA(1, 0), cA + kstep, voffA); PG8_STAGE(PG8_SB(1, 1), cB + hstep + kstep, voffB);
        PG8_WAIT_V(6); PG8_BAR;
    }
    for (;;) {
        const bool has_next = S.next(ui + 1, nxt);
        const char* nA = has_next ? (const char*)g.A + (size_t)nxt.pm * tstep : cA; const char* nB = has_next ? (const char*)g.Bt + (size_t)nxt.pn * tstep : cB;
        for (int t = 0; t < nt; t += 2) {
            const bool last = (t == nt - 2);
            const char* a1 = cA + (size_t)(t + 1) * kstep;
            const char* a2 = last ? nA : cA + (size_t)(t + 2) * kstep; const char* b2 = last ? nB : cB + (size_t)(t + 2) * kstep;
            const char* a3 = a2 + kstep; const char* b3 = b2 + kstep;
            if (last && has_next) S.a_ready(nxt);
            if constexpr (SP2) {
            PG8_LDB(B0, 0, 0); PG8_LDB(B1, 0, 1); PG8_SCHED; PG8_LDA(At, 0, 0); PG8_STAGE(PG8_SA(1, 1), a1 + hstep, voffA);
            PG8_WAIT_V(8); PG8_WAIT_L(0); PG8_BAR; PG8_MMA(0, 0, At, B0); PG8_MMA(0, 1, At, B1); PG8_BAR; PG8_SCHED;
            PG8_LDA(At, 0, 1); PG8_STAGE(PG8_SB(0, 0), b2, voffB); PG8_STAGE(PG8_SB(0, 1), b2 + hstep, voffB); PG8_STAGE(PG8_SA(0, 0), a2, voffA);
            PG8_WAIT_V(8); PG8_WAIT_L(0); PG8_BAR; PG8_MMA(1, 0, At, B0); PG8_MMA(1, 1, At, B1); PG8_BAR; PG8_SCHED;
            PG8_LDB(B0, 1, 0); PG8_LDB(B1, 1, 1); PG8_SCHED; PG8_LDA(At, 1, 0); PG8_STAGE(PG8_SA(0, 1), a2 + hstep, voffA);
            PG8_WAIT_V(8); PG8_WAIT_L(0); PG8_BAR; PG8_MMA(0, 0, At, B0); PG8_MMA(0, 1, At, B1); PG8_BAR; PG8_SCHED;
            PG8_LDA(At, 1, 1); PG8_STAGE(PG8_SB(1, 0), b3, voffB); PG8_STAGE(PG8_SB(1, 1), b3 + hstep, voffB); PG8_STAGE(PG8_SA(1, 0), a3, voffA);
            PG8_WAIT_V(8); PG8_WAIT_L(0); PG8_BAR; PG8_MMA(1, 0, At, B0); PG8_MMA(1, 1, At, B1); PG8_BAR; PG8_SCHED;
            } else {
            PG8_LDB(B0, 0, 0); PG8_SCHED; PG8_LDA(At, 0, 0); PG8_STAGE(PG8_SA(1, 1), a1 + hstep, voffA);
            PG8_WAIT_L(8); PG8_BAR; PG8_WAIT_L(0); PG8_MMA(0, 0, At, B0); PG8_BAR; PG8_SCHED;
            PG8_LDB(B1, 0, 1); PG8_STAGE(PG8_SB(0, 0), b2, voffB);
            PG8_BAR; PG8_WAIT_L(0); PG8_MMA(0, 1, At, B1); PG8_BAR;
            PG8_LDA(At, 0, 1); PG8_STAGE(PG8_SA(0, 0), a2, voffA);
            PG8_BAR; PG8_WAIT_L(0); PG8_MMA(1, 0, At, B0); PG8_BAR; PG8_SCHED;
            PG8_STAGE(PG8_SB(0, 1), b2 + hstep, voffB);
            PG8_WAIT_V(6); PG8_BAR; PG8_MMA(1, 1, At, B1); PG8_BAR;
            PG8_LDB(B0, 1, 0); PG8_SCHED; PG8_LDA(At, 1, 0); PG8_STAGE(PG8_SA(0, 1), a2 + hstep, voffA);
            PG8_WAIT_L(8); PG8_BAR; PG8_WAIT_L(0); PG8_MMA(0, 0, At, B0); PG8_BAR; PG8_SCHED;
            PG8_LDB(B1, 1, 1); PG8_STAGE(PG8_SB(1, 0), b3, voffB);
            PG8_BAR; PG8_WAIT_L(0); PG8_MMA(0, 1, At, B1); PG8_BAR;
            PG8_LDA(At, 1, 1); PG8_STAGE(PG8_SA(1, 0), a3, voffA);
            PG8_BAR; PG8_WAIT_L(0); PG8_MMA(1, 0, At, B0); PG8_BAR; PG8_SCHED;
            PG8_STAGE(PG8_SB(1, 1), b3 + hstep, voffB);
            PG8_WAIT_V(6); PG8_BAR; PG8_MMA(1, 1, At, B1); PG8_BAR;
            }
        }
        if constexpr (ALIGN_EPI) { if (wr == 0) PG8_BAR; }
        if constexpr (!Epi::AFTER_DRAIN) { E(acc, cur, wr, wc, fr, fq); S.done(cur); }
        if (!has_next) break;
#pragma unroll
        for (int a = 0; a < 2; ++a)
#pragma unroll
            for (int b = 0; b < 2; ++b)
#pragma unroll
                for (int m = 0; m < 4; ++m)
#pragma unroll
                    for (int n = 0; n < 2; ++n) acc[a][b][m][n] = (f32x4){0.f, 0.f, 0.f, 0.f};
        cur = nxt; cA = nA; cB = nB; ++ui;
        if constexpr (ALIGN_EPI) { if (wr == 1) PG8_BAR; }
    }
    PG8_WAIT_V(0);
    if constexpr (!ALIGN_EPI) { if (wr == 0) PG8_BAR; }
    PG8_BAR;
    if constexpr (Epi::AFTER_DRAIN) { E.fused(acc, cur, wr, wc, fr, fq, lds, wid, lane); S.done(cur); }
#undef PG8_SA
#undef PG8_SB
#undef PG8_STAGE
#undef PG8_LDA
#undef PG8_LDB
#undef PG8_MMA
#undef PG8_WAIT_V
#undef PG8_WAIT_L
#undef PG8_BAR
#undef PG8_SCHED
}
}

#define GAS __attribute__((address_space(1)))
#define LAS __attribute__((address_space(3)))
typedef unsigned short bf16;
typedef unsigned v4u __attribute__((ext_vector_type(4)));
typedef float f32x4 __attribute__((ext_vector_type(4)));
typedef short bf16x8 __attribute__((ext_vector_type(8)));
typedef GAS unsigned gu32;
typedef GAS unsigned long long gu64;
#define RLX_AGENT __ATOMIC_RELAXED, __HIP_MEMORY_SCOPE_AGENT
#define LDS_WAIT() asm volatile("s_waitcnt lgkmcnt(0)" ::: "memory")
#define VM_WAIT() asm volatile("s_waitcnt vmcnt(0)" ::: "memory")
__device__ __forceinline__ unsigned long long rt() { return __builtin_amdgcn_s_memrealtime(); }
__device__ __forceinline__ unsigned f2bf(float f) { unsigned u = __builtin_bit_cast(unsigned, f); return (u + 0x7fffu + ((u >> 16) & 1u)) >> 16; }
__device__ __forceinline__ unsigned pk2(float lo, float hi) { return f2bf(lo) | (f2bf(hi) << 16); }

#define XB_TMO      128
#define XB_XCNT(j)  (256  + 64 * (j))
#define XB_XSUB(j)  (1280 + 64 * (j))
#define XB_XGEN(j)  (2304 + 64 * (j))
#define XB_TOP      3328
#define XB_TOPGEN   3392
#define XCD_BAR_WORDS 3456
#define XB_SPIN_CAP (1u << 18)

__device__ __forceinline__ unsigned xb_ld(unsigned* p)              { return __hip_atomic_load(p, __ATOMIC_RELAXED, __HIP_MEMORY_SCOPE_AGENT); }
__device__ __forceinline__ unsigned xb_add(unsigned* p, unsigned v) { return __hip_atomic_fetch_add(p, v, __ATOMIC_RELAXED, __HIP_MEMORY_SCOPE_AGENT); }
__device__ __forceinline__ unsigned xb_xcc_id() { return (unsigned)__builtin_amdgcn_s_getreg((3 << 11) | 20) & 0xFu; }
#define XB_SPIN(cond, bar) do { unsigned _sp = 0; while (cond) { __builtin_amdgcn_s_sleep(1); \
    if ((++_sp & 255u) == 0u) { if (xb_ld(&(bar)[XB_TMO])) break; if (_sp > XB_SPIN_CAP) { atomicAdd(&(bar)[XB_TMO], 1u); break; } } } } while (0)

struct XcdBarrier {
    int wave;
    unsigned* bar; unsigned x;
    volatile LAS unsigned* st;
};

__device__ __forceinline__ XcdBarrier xcd_barrier_post(unsigned* bar, volatile LAS unsigned* st, int wave) {
    XcdBarrier b; b.wave = wave; b.bar = bar; b.x = xb_xcc_id(); b.st = st;
    if (wave == 0 && lane_id_() == 0) (void)xb_add(&bar[XB_XCNT(b.x)], 1u);
    return b;
}
__device__ __forceinline__ void xcd_barrier_complete(unsigned* bar, unsigned x, unsigned& nloc, unsigned& nx) {
    const unsigned G = gridDim.x * gridDim.y * gridDim.z;
    unsigned sum, cnt, mine, sp = 0u;
    for (;;) {
        sum = 0u; cnt = 0u; mine = 0u;
#pragma unroll
        for (unsigned j = 0; j < 16; ++j) { const unsigned c = xb_ld(&bar[XB_XCNT(j)]); sum += c; cnt += (c > 0u) ? 1u : 0u; mine = (j == x) ? c : mine; }
        if (sum == G) break;
        __builtin_amdgcn_s_sleep(1);
        if ((++sp & 255u) == 0u) { if (xb_ld(&bar[XB_TMO])) break; if (sp > XB_SPIN_CAP) { atomicAdd(&bar[XB_TMO], 1u); break; } }
    }
    nloc = mine > 0u ? mine : 1u; nx = cnt > 0u ? cnt : 1u;
}

__device__ __forceinline__ void xcd_barrier(const XcdBarrier& b) {
    asm volatile("s_waitcnt vmcnt(0)" ::: "memory");
    __syncthreads();
    if (b.wave == 0 && lane_id_() == 0) {
        unsigned* bar = b.bar;
        __builtin_amdgcn_s_waitcnt(0);
        unsigned nloc = b.st[0], nx = b.st[1];
        if (nloc == 0u) { xcd_barrier_complete(bar, b.x, nloc, nx); b.st[0] = nloc; b.st[1] = nx; }
        const unsigned old = xb_add(&bar[XB_XSUB(b.x)], 1u);
        const unsigned gen = old / nloc;
        if (old + 1u == (gen + 1u) * nloc) {
            __builtin_amdgcn_fence(__ATOMIC_RELEASE, "agent");
            asm volatile("s_waitcnt vmcnt(0)" ::: "memory");
            const unsigned og = xb_add(&bar[XB_TOP], 1u);
            const unsigned tg = og / nx;
            if (og + 1u == (tg + 1u) * nx) xb_add(&bar[XB_TOPGEN], 1u);
            else XB_SPIN(xb_ld(&bar[XB_TOPGEN]) == tg, bar);
            __builtin_amdgcn_fence(__ATOMIC_ACQUIRE, "agent");
            xb_add(&bar[XB_XGEN(b.x)], 1u);
            asm volatile("s_waitcnt vmcnt(0)" ::: "memory");
        } else {
            XB_SPIN(xb_ld(&bar[XB_XGEN(b.x)]) == gen, bar);
            __builtin_amdgcn_fence(__ATOMIC_ACQUIRE, "agent");
            asm volatile("s_waitcnt vmcnt(0)" ::: "memory");
        }
    }
    __syncthreads();
}

__device__ __forceinline__ void xcd_barrier_local(const XcdBarrier& b) {
    asm volatile("s_waitcnt vmcnt(0)" ::: "memory");
    __syncthreads();
    if (b.wave == 0 && lane_id_() == 0) {
        unsigned* bar = b.bar;
        __builtin_amdgcn_s_waitcnt(0);
        const unsigned nloc = b.st[0];
        const unsigned old = xb_add(&bar[XB_XSUB(b.x)], 1u);
        const unsigned gen = old / nloc;
        if (old + 1u == (gen + 1u) * nloc) xb_add(&bar[XB_XGEN(b.x)], 1u);
        else XB_SPIN(xb_ld(&bar[XB_XGEN(b.x)]) == gen, bar);
        __builtin_amdgcn_fence(__ATOMIC_ACQUIRE, "agent");
        asm volatile("s_waitcnt vmcnt(0)" ::: "memory");
    }
    __syncthreads();
}

constexpr int NWAVES = 8;
#ifndef MK_PER_PHASE
#define MK_PER_PHASE 0
#endif
constexpr int BATCH = 4, T = 8192, D = 1024, M = BATCH * T;
constexpr int MEML = 256, MROWS = BATCH * MEML;
constexpr int AW = 512, HD = 128, NIH = 16, IDIM = 64;
constexpr int TOPK = 256;
constexpr int NIN = 3152, NINP = 3328;
constexpr int DFF = 2816, CW = 31, CHD = 256;
constexpr float EPS = 1e-6f;

constexpr size_t MiB = 1u << 20;
constexpr size_t WS_CTL = 0, CTL_ZERO_BYTES = 1 * MiB;
constexpr size_t WS_WIN = 1 * MiB;
constexpr size_t WS_WOUT = 8 * MiB;
constexpr size_t WS_WCIN = 10 * MiB;
constexpr size_t WS_WCOUT = 14 * MiB;
constexpr size_t WS_WCQ = 16 * MiB;
constexpr size_t WS_WCO = 20 * MiB;
constexpr size_t WS_WCKV = 24 * MiB;
constexpr size_t WS_WGU = 32 * MiB;
constexpr size_t WS_WDN = 54 * MiB;
constexpr size_t WS_MEMN = 65 * MiB;
constexpr size_t WS_MKV = 69 * MiB;
constexpr size_t WS_XN = 80 * MiB;
constexpr size_t WS_BM = 144 * MiB;
constexpr size_t WS_PROJ = 176 * MiB;
constexpr size_t PROJ_T = (size_t)M * 256 * 2;
constexpr size_t WS_HID = WS_PROJ;
constexpr size_t WS_CQ = WS_PROJ;
constexpr size_t WS_CO = WS_PROJ + 64 * MiB;
constexpr size_t WS_G = WS_PROJ;
constexpr size_t WS_IKT = WS_PROJ + 13 * PROJ_T;
constexpr size_t WS_HB2 = WS_IKT + 4 * MiB;
constexpr size_t WS_SSQ = WS_HB2 + 64 * MiB;
constexpr size_t SSQ_BYTES = (size_t)M * 16 * 4;
constexpr size_t WS_END = WS_SSQ + 5 * SSQ_BYTES;
constexpr int CW_TMO = 0, CW_MIS = 64, CW_D1Q = 128, CW_BAR = 4096;

constexpr int RING_OFF = 0, RING_BYTES = 131072;
constexpr int LDSCTL_OFF = RING_BYTES, MISC_OFF = LDSCTL_OFF + 320;
constexpr int LDS_BYTES = 147456;

namespace dsa2 {
constexpr int D = 128, LDQ = 256, LDO = 1024, MWT = 8192;
constexpr float THR = 8.f;
constexpr bool WSKIP = false;

constexpr float SCALE = 0.08838834764831845f;
constexpr int NW = 8, QBLK = 32, KVBLK = 64, QB = NW * QBLK;
constexpr int SHM_V = KVBLK * D * 2, SHM_K = KVBLK * D * 2;
constexpr int LDS_BYTES = 2 * SHM_V + 2 * SHM_K + NW * 64 * 4;
typedef short s16x4 __attribute__((ext_vector_type(4)));
typedef float f32x16 __attribute__((ext_vector_type(16)));
typedef unsigned u32x4 __attribute__((ext_vector_type(4)));
template <class A, class Bt> struct same_t { static constexpr bool v = false; };
template <class A> struct same_t<A, A> { static constexpr bool v = true; };

#define KSWZ(row, colB) ((row) * 256 + ((colB) ^ (((row) & 7) << 4)))
#define SBAR() __builtin_amdgcn_sched_barrier(0)
__device__ __forceinline__ int v_st(int k, int c) { const int kk = (k & ~0xC) | ((k & 4) << 1) | ((k & 8) >> 1); return ((kk >> 3) * 4 + (c >> 5)) * 512 + ((kk & 7) * 32 + (c & 31)) * 2; }
__device__ __forceinline__ int v_rd_base(int lane) { return ((lane & 3) << 3) | (((lane >> 2) & 3) << 6) | (((lane >> 4) & 1) << 5) | (((lane >> 5) & 1) << 8); }
constexpr int v_rd_off(int d0, int ks, int half) { return d0 * 512 + ks * 4096 + half * 2048; }
__device__ __forceinline__ int crow(int r, int hi) { return (r & 3) + 8 * (r >> 2) + 4 * hi; }
__device__ __forceinline__ unsigned cvtpk(float lo, float hi) {
    unsigned r; asm volatile("v_cvt_pk_bf16_f32 %0, %1, %2" : "=v"(r) : "v"(lo), "v"(hi)); return r;
}
__device__ __forceinline__ bf16x8 pack8(f32x4 a, f32x4 b) {
    u32x4 w = {cvtpk(a[0], a[1]), cvtpk(a[2], a[3]), cvtpk(b[0], b[1]), cvtpk(b[2], b[3])};
    return *reinterpret_cast<bf16x8*>(&w);
}
template <class T> __device__ __forceinline__ bf16x8 load8(const T* p) {
    if constexpr (same_t<T, float>::v) { return pack8(*(const f32x4*)p, *(const f32x4*)(p + 4)); }
    else { return *reinterpret_cast<const bf16x8*>(p); }
}
__device__ __forceinline__ void mask_tile(f32x16& p0, f32x16& p1, int dq, unsigned W) {
    const float NEG = -__builtin_inff();
#pragma unroll
    for (int r = 0; r < 16; ++r) {
        const int c = (r & 3) + 8 * (r >> 2);
        if ((unsigned)(dq - c) >= W) p0[r] = NEG;
        if ((unsigned)(dq - c - 32) >= W) p1[r] = NEG;
    }
}
__device__ __forceinline__ void mask_bits(f32x16& p0, f32x16& p1, unsigned mh, int hi) {
    const float NEG = -__builtin_inff();
    auto rr = __builtin_amdgcn_permlane32_swap(mh, mh, false, false);
    const unsigned lo = (unsigned)rr[0] >> (4 * hi), hh = (unsigned)rr[1] >> (4 * hi);
#pragma unroll
    for (int r = 0; r < 16; ++r) {
        const int c = (r & 3) + 8 * (r >> 2);
        if (!((lo >> c) & 1u)) p0[r] = NEG;
        if (!((hh >> c) & 1u)) p1[r] = NEG;
    }
}
__device__ __forceinline__ void partialSM_s(f32x16& p0, f32x16& p1, float& m_reg, float& mn, float& alpha, const float SCALE) {
    float pmax = p0[0]; for (int r = 1; r < 16; ++r) pmax = fmaxf(pmax, p0[r]); for (int r = 0; r < 16; ++r) pmax = fmaxf(pmax, p1[r]);
    { auto rr = __builtin_amdgcn_permlane32_swap(__float_as_uint(pmax), __float_as_uint(pmax), false, false);
      pmax = fmaxf(__uint_as_float(rr[0]), __uint_as_float(rr[1])); }
    const float C2 = 1.4426950408889634f * SCALE;
    if (__builtin_expect(__all((pmax - m_reg) * SCALE <= THR), 1)) { mn = m_reg; alpha = 1.f; }
    else { mn = fmaxf(m_reg, pmax); alpha = __builtin_amdgcn_exp2f((m_reg - mn) * C2); m_reg = mn; }
    const float mnL = -mn * C2;
    for (int r = 0; r < 16; ++r) p0[r] = fmaf(p0[r], C2, mnL); for (int r = 0; r < 16; ++r) p1[r] = fmaf(p1[r], C2, mnL);
    for (int r = 0; r < 16; ++r) p0[r] = __builtin_amdgcn_exp2f(p0[r]);
}
__device__ __forceinline__ void partialSM(f32x16& p0, f32x16& p1, float& m_reg, float& mn, float& alpha) { partialSM_s(p0, p1, m_reg, mn, alpha, SCALE); }
__device__ __forceinline__ void finishSM(f32x16& p0, f32x16& p1, float alpha, float& l_reg, bf16x8& pa0, bf16x8& pa1, bf16x8& pa2, bf16x8& pa3) {
    for (int r = 0; r < 16; ++r) p1[r] = __builtin_amdgcn_exp2f(p1[r]);
    float ps = 0; for (int r = 0; r < 16; ++r) ps += p0[r]; for (int r = 0; r < 16; ++r) ps += p1[r];
    { auto rr = __builtin_amdgcn_permlane32_swap(__float_as_uint(ps), __float_as_uint(ps), false, false);
      ps = __uint_as_float(rr[0]) + __uint_as_float(rr[1]); }
    l_reg = l_reg * alpha + ps;
#define PK4(P, B_, OUT) do { unsigned a0 = cvtpk(P[B_+0], P[B_+1]), a1 = cvtpk(P[B_+2], P[B_+3]);                          \
        unsigned b0 = cvtpk(P[B_+4], P[B_+5]), b1 = cvtpk(P[B_+6], P[B_+7]);                                             \
        auto r0 = __builtin_amdgcn_permlane32_swap(a0, b0, false, false); auto r1 = __builtin_amdgcn_permlane32_swap(a1, b1, false, false); \
        u32x4 w = {r0[0], r1[0], r0[1], r1[1]}; OUT = *reinterpret_cast<bf16x8*>(&w); } while (0)
    PK4(p0, 0, pa0); PK4(p0, 8, pa1); PK4(p1, 0, pa2); PK4(p1, 8, pa3);
#undef PK4
}
template <int KB, bool SK>
__device__ __forceinline__ void qkt(f32x16& p0, f32x16& p1, const char* K_lds, int r32, int hi, const bf16x8* qr, bool act) {
    if (SK && !act) { const float NEG = -__builtin_inff();
#pragma unroll
        for (int r = 0; r < 16; ++r) { p0[r] = NEG; p1[r] = NEG; } return; }
    p0 = f32x16{}; p1 = f32x16{};
    const char* kb[4];
#pragma unroll
    for (int dd = 0; dd < 4; ++dd) kb[dd] = K_lds + KB * SHM_K + KSWZ(r32, (dd * 16 + hi * 8) * 2);
#pragma unroll
    for (int d0 = 0; d0 < 8; ++d0) { const char* a = kb[d0 & 3] + (d0 >> 2) * 128;
        bf16x8 b0 = *reinterpret_cast<const bf16x8*>(a);
        bf16x8 b1 = *reinterpret_cast<const bf16x8*>(a + 32 * 256);
        p0 = __builtin_amdgcn_mfma_f32_32x32x16_bf16(b0, qr[d0], p0, 0, 0, 0);
        p1 = __builtin_amdgcn_mfma_f32_32x32x16_bf16(b1, qr[d0], p1, 0, 0, 0); }
}
template <int VB, bool SK>
__device__ __forceinline__ void pv_tile(f32x16* o, int vb0, bf16x8 pa0, bf16x8 pa1, bf16x8 pa2, bf16x8 pa3, bool act) {
    if (SK && !act) return;
#define TRRD(dst, off) asm volatile("ds_read_b64_tr_b16 %0, %1 offset:%2" : "=&v"(dst) : "v"(vb0), "i"(off) : "memory")
#define PV_D0(d0) do { s16x4 l0, l1, l2, l3, h0, h1, h2, h3; constexpr int b_ = VB * SHM_V + v_rd_off(d0, 0, 0);     \
        TRRD(l0, b_); TRRD(h0, b_ + 2048); TRRD(l1, b_ + 4096); TRRD(h1, b_ + 6144); TRRD(l2, b_ + 8192); TRRD(h2, b_ + 10240); TRRD(l3, b_ + 12288); TRRD(h3, b_ + 14336); \
        asm volatile("s_waitcnt lgkmcnt(0)" ::: "memory"); SBAR();                 \
        o[d0] = __builtin_amdgcn_mfma_f32_32x32x16_bf16(pa0, (bf16x8){l0[0], l0[1], l0[2], l0[3], h0[0], h0[1], h0[2], h0[3]}, o[d0], 0, 0, 0);   \
        o[d0] = __builtin_amdgcn_mfma_f32_32x32x16_bf16(pa1, (bf16x8){l1[0], l1[1], l1[2], l1[3], h1[0], h1[1], h1[2], h1[3]}, o[d0], 0, 0, 0);   \
        o[d0] = __builtin_amdgcn_mfma_f32_32x32x16_bf16(pa2, (bf16x8){l2[0], l2[1], l2[2], l2[3], h2[0], h2[1], h2[2], h2[3]}, o[d0], 0, 0, 0);   \
        o[d0] = __builtin_amdgcn_mfma_f32_32x32x16_bf16(pa3, (bf16x8){l3[0], l3[1], l3[2], l3[3], h3[0], h3[1], h3[2], h3[3]}, o[d0], 0, 0, 0); } while (0)
    PV_D0(0); PV_D0(1); PV_D0(2); PV_D0(3);
#undef PV_D0
#undef TRRD
}

template <class TIn, class TOut> struct BlockRef { const TIn* Q; const TIn* K; const TIn* V; TOut* O; const unsigned long long* MW; int P0; };
template <class TIn> struct Seam {
    bf16x8 qr[8];
    bf16x8 st_k0, st_k1;
    f32x4 tq[1];
};
__device__ __forceinline__ int swa_jlo(int P0, int W) { const int lowk = P0 - W + 1; return lowk > 0 ? lowk / KVBLK : 0; }
#define ROW(p, k0, rr) ((p) + (size_t)((k0) + (rr)) * LDQ + sc)
#define VMW() asm volatile("s_waitcnt vmcnt(0)" ::: "memory")
#define VMWN(n) asm volatile("s_waitcnt vmcnt(%0)" :: "i"(n) : "memory")
#define SLOAD_H(Kp, Vp, k0) do { S.st_v0 = load8<TIn>(ROW(Vp, k0, sr)); S.st_v1 = load8<TIn>(ROW(Vp, k0, 32 + sr));              \
                         S.st_k0 = load8<TIn>(ROW(Kp, k0, sr)); S.st_k1 = load8<TIn>(ROW(Kp, k0, 32 + sr)); } while (0)
#define SWRITE_HK(bf) do { *(bf16x8*)(K_lds + (bf) * SHM_K + kws) = S.st_k0; *(bf16x8*)(K_lds + (bf) * SHM_K + kws + 32 * 256) = S.st_k1; } while (0)
#define SWRITE_HV(bf) do { *(bf16x8*)(V_lds + (bf) * SHM_V + vst0) = S.st_v0; *(bf16x8*)(V_lds + (bf) * SHM_V + vst1) = S.st_v1; } while (0)
#define SWRITE_H(bf) do { SWRITE_HV(bf); SWRITE_HK(bf); } while (0)
#define SLOAD_F(p, k0) do { S.st_k0 = load8<TIn>(ROW(p, k0, sr)); S.st_k1 = load8<TIn>(ROW(p, k0, 32 + sr)); } while (0)
#define SWRITE_KF(bf) do { *(bf16x8*)(K_lds + (bf) * SHM_K + kws) = S.st_k0; *(bf16x8*)(K_lds + (bf) * SHM_K + kws + 32 * 256) = S.st_k1; } while (0)
#define SWRITE_VF(bf) do { *(bf16x8*)(V_lds + (bf) * SHM_V + vst0) = S.st_k0; *(bf16x8*)(V_lds + (bf) * SHM_V + vst1) = S.st_k1; } while (0)
template <class TIn, class TOut>
__device__ __forceinline__ void causal_swa_prime(const BlockRef<TIn, TOut>& cur, int W, char* lds, Seam<TIn>& S, const int wave_) {
    constexpr bool F32 = same_t<TIn, float>::v; constexpr bool TWOPH = true; static_assert(!F32, "bf16 K/V only");
    const int tid = otid(wave_), wid = wave_, lane = tid & 63, r32 = lane & 31, hi = lane >> 5;
    const int sr = tid >> 4, sc = (tid & 15) * 8, kws = KSWZ(sr, sc * 2); char* K_lds = lds + 2 * SHM_V;
    const int kb0 = swa_jlo(cur.P0, W) * KVBLK;
    for (int d0 = 0; d0 < 8; ++d0) S.qr[d0] = load8<TIn>(cur.Q + (size_t)(wid * QBLK + r32) * LDQ + d0 * 16 + hi * 8);
    if constexpr (TWOPH) { SLOAD_F((cur.K), kb0); VMW(); SWRITE_KF(0); SBAR(); SLOAD_F((cur.V), kb0); }
    else { SLOAD_H(cur.K, cur.V, kb0); VMW(); SWRITE_HK(0); }
    __syncthreads();
}
template <class TIn, class TOut>
__device__ __forceinline__ void causal_swa_block(const BlockRef<TIn, TOut>& cur, const BlockRef<TIn, TOut>& nxt, int skv, int W, char* lds, Seam<TIn>& S, const int wave_) {
    constexpr bool F32 = same_t<TIn, float>::v;
    const int tid = otid(wave_), wid = wave_, lane = tid & 63, r32 = lane & 31, hi = lane >> 5;
    const int j_lo = swa_jlo(cur.P0, W);
    int j_hi = (cur.P0 + QB - 1) / KVBLK + 1; if (j_hi > skv / KVBLK) j_hi = skv / KVBLK;
    const int NT = j_hi - j_lo;
    const int kbn = swa_jlo(nxt.P0, W) * KVBLK;
    const int qlo = cur.P0 + wid * QBLK, qm = qlo + r32 - 4 * hi;
    char* V_lds = lds; char* K_lds = lds + 2 * SHM_V;
    float* ws = (float*)(lds + 2 * SHM_V + 2 * SHM_K) + wid * 64; float* li_l = ws, * al_l = ws + 32;
    float m_reg = -1e30f, l_reg = 0; f32x16 o[4] = {};
    const int sr = tid >> 4, sc = (tid & 15) * 8, vst0 = v_st(sr, sc), vst1 = v_st(32 + sr, sc), kws = KSWZ(sr, sc * 2);
    const int vb0 = (int)(uintptr_t)V_lds + v_rd_base(lane);
    const TIn* Kh = cur.K; const TIn* Vh = cur.V;
#define RESC(a) do { if (__any((a) < 1.f)) { if (hi == 0) al_l[r32] = (a); asm volatile("s_waitcnt lgkmcnt(0)" ::: "memory");              \
                     for (int d_ = 0; d_ < 4; ++d_) for (int r = 0; r < 16; ++r) o[d_][r] *= al_l[crow(r, hi)]; } } while (0)
#define KBASE(t) ((j_lo + (t)) * KVBLK)
#define ACT(t) (KBASE(t) <= qlo + QBLK - 1 && KBASE(t) + KVBLK - 1 >= qlo - W + 1)
#define MASKT(P0_, P1_, t, MWX) do { mask_bits(P0_, P1_, MWX, hi); } while (0)
#define MWLD(t) (((const unsigned*)cur.MW)[((size_t)(j_lo + (t)) * MWT + qlo + r32) * 2 + hi])
    constexpr int NQL = F32 ? 16 : 8; constexpr bool TWOPH = true;
    constexpr bool SK = WSKIP && !F32;
#define SEAM_K0() do { VMWN(NQL); if constexpr (TWOPH) { SWRITE_KF(0); SBAR(); SLOAD_F((nxt.V), kbn); } else { SWRITE_HK(0); } SBAR(); } while (0)
    f32x16 pA0, pA1, pB0, pB1; float mnA, mnB, alA, alB; bf16x8 pa0, pa1, pa2, pa3;
    if constexpr (TWOPH) { VMW(); SWRITE_VF(0); SBAR(); } else { SWRITE_HV(0); SBAR(); }
    if (NT > 1) { if constexpr (TWOPH) SLOAD_F((Kh), KBASE(1)); else SLOAD_H(Kh, Vh, KBASE(1)); }
    unsigned mwA = MWLD(0); SBAR();     qkt<0, SK>(pA0, pA1, K_lds, r32, hi, S.qr, ACT(0));
    if constexpr (TWOPH) { if (NT > 1) { VMW(); SWRITE_KF(1); SBAR(); SLOAD_F((Vh), KBASE(1)); } }
    MASKT(pA0, pA1, 0, mwA); partialSM(pA0, pA1, m_reg, mnA, alA);
    if (NT > 1) { VMW(); if constexpr (TWOPH) { SWRITE_VF(1); SBAR(); if (NT > 2) SLOAD_F((Kh), KBASE(2)); } else SWRITE_H(1); }
    __syncthreads();
#define HALF_STEP(PX0, PX1, mnX, alX, PY0, PY1, alY, t, KB, VB, SB, MWX) do {                                                 \
        MWX = MWLD(t); SBAR(); qkt<KB, SK>(PX0, PX1, K_lds, r32, hi, S.qr, ACT(t));                              \
        finishSM(PY0, PY1, alY, l_reg, pa0, pa1, pa2, pa3); SBAR();                                                           \
        if ((t) + 1 < NT) { if constexpr (TWOPH) { VMW(); SWRITE_KF(SB); SBAR(); SLOAD_F((Vh), KBASE((t) + 1)); }  \
                            else { SLOAD_H(Kh, Vh, KBASE((t) + 1)); } SBAR(); }                                               \
        pv_tile<VB, SK>(o, vb0, pa0, pa1, pa2, pa3, ACT((t) - 1)); MASKT(PX0, PX1, (t), MWX); partialSM(PX0, PX1, m_reg, mnX, alX);                                        \
        __syncthreads();                                                                                                      \
        if ((t) + 1 < NT) { VMW(); if constexpr (TWOPH) { SWRITE_VF(SB); SBAR(); if ((t) + 2 < NT) SLOAD_F((Kh), KBASE((t) + 2)); } \
                            else { SWRITE_H(SB); } }                                                                          \
        RESC(alX); __syncthreads(); } while (0)
    for (int t = 1; t + 1 < NT; t += 2) {
        HALF_STEP(pB0, pB1, mnB, alB, pA0, pA1, alA, t, 1, 0, 0, mwA);
        HALF_STEP(pA0, pA1, mnA, alA, pB0, pB1, alB, t + 1, 0, 1, 1, mwA);
    }
    const bool even = (NT & 1) == 0;
    if (even) { mwA = MWLD(NT - 1); SBAR(); qkt<1, SK>(pB0, pB1, K_lds, r32, hi, S.qr, ACT(NT - 1)); SBAR(); }
#define QROW(e) (nxt.Q + (size_t)(wid * QBLK + r32) * LDQ + ((e) >> 1) * 16 + hi * 8 + ((e) & 1) * 4)
    if constexpr (F32) { SBAR();
#pragma unroll
        for (int e = 0; e < 8; ++e) S.tq[e] = *(const f32x4*)QROW(e); }
    else { SLOAD_F((nxt.K), kbn); SBAR();
#pragma unroll
        for (int d0 = 0; d0 < 8; ++d0) S.qr[d0] = load8<TIn>(nxt.Q + (size_t)(wid * QBLK + r32) * LDQ + d0 * 16 + hi * 8); }
    SBAR();
    finishSM(pA0, pA1, alA, l_reg, pa0, pa1, pa2, pa3); SBAR();
    if constexpr (F32) {
#pragma unroll
        for (int e = 8; e < 16; ++e) S.tq[e] = *(const f32x4*)QROW(e); SBAR(); }
#undef QROW
    pv_tile<0, SK>(o, vb0, pa0, pa1, pa2, pa3, ACT(even ? NT - 2 : NT - 1));
    if (even) { MASKT(pB0, pB1, NT - 1, mwA); partialSM(pB0, pB1, m_reg, mnB, alB); __syncthreads(); RESC(alB);
        finishSM(pB0, pB1, alB, l_reg, pa0, pa1, pa2, pa3); SBAR(); pv_tile<1, SK>(o, vb0, pa0, pa1, pa2, pa3, ACT(NT - 1)); }
    SBAR(); SEAM_K0();
    if (hi == 0) li_l[r32] = l_reg; asm volatile("s_waitcnt lgkmcnt(0)" ::: "memory");
    float rli[16];
#pragma unroll
    for (int r = 0; r < 16; ++r) rli[r] = __builtin_amdgcn_rcpf(li_l[crow(r, hi)]);
    TOut* Ow = cur.O + (size_t)(wid * QBLK) * LDO;
#pragma unroll
    for (int r = 0; r < 16; ++r) { const int orow = crow(r, hi);
#pragma unroll
        for (int d0 = 0; d0 < 4; ++d0) { const float v = o[d0][r] * rli[r];
            if constexpr (same_t<TOut, float>::v) { Ow[(size_t)orow * LDO + d0 * 32 + r32] = v; }
            else { const float vn = __shfl_xor(v, 1);
                   if ((r32 & 1) == 0) *(unsigned*)(Ow + (size_t)orow * LDO + d0 * 32 + r32) = cvtpk(v, vn); } } }
    if constexpr (F32) {
#pragma unroll
        for (int d0 = 0; d0 < 8; ++d0) S.qr[d0] = pack8(S.tq[2 * d0], S.tq[2 * d0 + 1]); }
    __syncthreads();
#undef RESC
#undef KBASE
#undef ACT
#undef MASKT
#undef MWLD
#undef SEAM_K0
#undef HALF_STEP
}
#undef ROW
#undef VMW
#undef VMWN
#undef SLOAD_H
#undef SWRITE_HK
#undef SWRITE_HV
#undef SWRITE_H
#undef SLOAD_F
#undef SWRITE_KF
#undef SWRITE_VF


}

typedef float f32x16 __attribute__((ext_vector_type(16)));
typedef float f32x2 __attribute__((ext_vector_type(2)));
typedef unsigned long long u64;
struct Frame {
    LAS unsigned char* lds;
    volatile LAS unsigned* MISC;
    gu32* ctl;
    int tid, lane, wave, G;
};
__device__ __forceinline__ float wave_sum_dpp(float v) {
#define WS_DPP(ctrl, rmask) v += __builtin_bit_cast(float, __builtin_amdgcn_update_dpp(0, __builtin_bit_cast(int, v), ctrl, rmask, 0xf, true))
    WS_DPP(0xB1, 0xf); WS_DPP(0x4E, 0xf); WS_DPP(0x141, 0xf); WS_DPP(0x140, 0xf); WS_DPP(0x142, 0xa); WS_DPP(0x143, 0xc);
#undef WS_DPP
    return __builtin_bit_cast(float, __builtin_amdgcn_readlane(__builtin_bit_cast(int, v), 63));
}
__device__ __forceinline__ float wave_sum(float v) {
#pragma unroll
    for (int o = 1; o < 64; o <<= 1) v += __shfl_xor(v, o);
    return v;
}
__device__ __forceinline__ int wave_sum_i(int v) {
#pragma unroll
    for (int o = 1; o < 64; o <<= 1) v += __shfl_xor(v, o);
    return __builtin_amdgcn_readfirstlane(v);
}
__device__ __forceinline__ float bf_lo(unsigned u) { return __uint_as_float(u << 16); }
__device__ __forceinline__ float bf_hi(unsigned u) { return __uint_as_float(u & 0xffff0000u); }

__device__ __forceinline__ void tr_item(const float* W, int ldw, int nvalid, int k0, int n0, bf16* WT, int ldk, int drow0, int kcol0, LAS float* scr, int lane, const float* kgain = nullptr) {
    const int kr = lane >> 3, n4 = (lane & 7) * 4; const bool ok = n0 + n4 < nvalid;
    f32x4 v[8];
#pragma unroll
    for (int i = 0; i < 8; ++i) v[i] = ok ? *(const f32x4*)(W + (size_t)(k0 + 8 * i + kr) * ldw + n0 + n4) : (f32x4){0.f, 0.f, 0.f, 0.f};
#pragma unroll
    for (int i = 0; i < 8; ++i) { const int kk = 8 * i + kr; const float g = kgain ? kgain[k0 + kk] : 1.f;
#pragma unroll
        for (int j = 0; j < 4; ++j) scr[kk * 33 + n4 + j] = v[i][j] * g; }
    LDS_WAIT(); asm volatile("" ::: "memory");
    const int c = lane & 7;
#pragma unroll
    for (int j = 0; j < 4; ++j) { const int n = (lane >> 3) + 8 * j; const LAS float* s = scr + (8 * c) * 33 + n;
        v4u o; o.x = pk2(s[0 * 33], s[1 * 33]); o.y = pk2(s[2 * 33], s[3 * 33]); o.z = pk2(s[4 * 33], s[5 * 33]); o.w = pk2(s[6 * 33], s[7 * 33]);
        *(GAS v4u*)(WT + (size_t)(drow0 + n) * ldk + kcol0 + k0 + 8 * c) = o; }
    LDS_WAIT(); asm volatile("" ::: "memory");
}
__device__ __forceinline__ void rms_row_to_bf16(int lane, const float* xrow, const float* gain, bf16* orow) {
    const GAS f32x4* xr = (const GAS f32x4*)xrow + lane; const GAS f32x4* gr = (const GAS f32x4*)gain + lane;
    f32x4 v[4]; float s = 0.f;
#pragma unroll
    for (int j = 0; j < 4; ++j) { v[j] = xr[64 * j]; s += (v[j].x * v[j].x + v[j].y * v[j].y) + (v[j].z * v[j].z + v[j].w * v[j].w); }
    const float r = 1.f / sqrtf(wave_sum(s) * (1.f / D) + EPS);
    GAS u64* o8 = (GAS u64*)orow + lane;
#pragma unroll
    for (int j = 0; j < 4; ++j) { const f32x4 g = gr[64 * j]; o8[64 * j] = (u64)pk2(v[j].x * r * g.x, v[j].y * r * g.y) | ((u64)pk2(v[j].z * r * g.z, v[j].w * r * g.w) << 32); }
}
struct P0Args { const float *norm_cross, *norm_ffn; const float *x, *mem, *norm_mix, *norm_mem, *w_in_ab, *pool_w, *pool_scale, *w_out_ab, *conv_w_in, *conv_w_out, *cross_wq, *cross_wk, *cross_wv, *cross_wo, *ffn_w_gate, *ffn_w_up, *ffn_w_down; unsigned char* ws; };
__device__ __forceinline__ void p0_prologue(Frame& F, const P0Args& a) {
    LAS float* scr = (LAS float*)(F.lds + RING_OFF + F.wave * 16384);
    const int gw = blockIdx.x * NWAVES + F.wave, NGW = F.G * NWAVES, lane = otid(F.wave) & 63;
    unsigned char* ws = a.ws;
    constexpr int I_IN = 16 * (NINP / 32), I_OUTA = 8 * 32, I_CIN = 16 * 64, I_SQ = 16 * 32, I_GU = 16 * (DFF / 32), I_DN = (DFF / 64) * 32;
    constexpr int NITEMS = I_IN + I_OUTA + I_CIN + I_SQ + 8 * I_SQ + 4 * I_GU + 2 * I_DN;
    for (int it = gw; it < NITEMS; it += NGW) {
        int r = it;
        if (r < I_IN) { const int nb = NINP / 32, kb = r / nb, n0 = 32 * (r % nb); tr_item(a.w_in_ab, NIN, NIN, 64 * kb, n0, (bf16*)(ws + WS_WIN), D, n0, 0, scr, lane); continue; } r -= I_IN;
        if (r < I_OUTA) { const int kb = r / 32, n0 = 32 * (r % 32); tr_item(a.w_out_ab, D, D, 64 * kb, n0, (bf16*)(ws + WS_WOUT), D, n0, 0, scr, lane); continue; } r -= I_OUTA;
        if (r < I_CIN) { const int kb = r / 64, n0 = 32 * (r % 64), c = n0 & 1023, dr = 256 * (c >> 7) + (c & 127) + ((n0 >> 10) << 7); tr_item(a.conv_w_in, 2 * D, 2 * D, 64 * kb, n0, (bf16*)(ws + WS_WCIN), D, dr, 0, scr, lane, a.norm_mix + D); continue; } r -= I_CIN;
        if (r < I_SQ) { const int kb = r / 32, n0 = 32 * (r % 32); tr_item(a.conv_w_out, D, D, 64 * kb, n0, (bf16*)(ws + WS_WCOUT), D, n0, 0, scr, lane); continue; } r -= I_SQ;
        if (r < 8 * I_SQ) { const int mi = r / I_SQ, l = mi >> 2, which = mi & 3, q = r % I_SQ, kb = q / 32, n0 = 32 * (q % 32);
            const float* src = (which == 0 ? a.cross_wq : which == 1 ? a.cross_wk : which == 2 ? a.cross_wv : a.cross_wo) + (size_t)l * D * D;
            bf16* dst = which == 0 ? (bf16*)(ws + WS_WCQ) + (size_t)l * D * D : which == 3 ? (bf16*)(ws + WS_WCO) + (size_t)l * D * D : (bf16*)(ws + WS_WCKV) + (size_t)l * 2 * D * D + (which == 2 ? (size_t)D * D : 0);
            tr_item(src, D, D, 64 * kb, n0, dst, D, n0, 0, scr, lane, which == 0 ? a.norm_cross + l * D : nullptr); continue; } r -= 8 * I_SQ;
        if (r < 4 * I_GU) { const int mi = r / I_GU, l = mi >> 1, up = mi & 1, q = r % I_GU, nb = DFF / 32, kb = q / nb, n0 = 32 * (q % nb), dr = 256 * (n0 >> 7) + (n0 & 127) + 128 * up;
            const float* src = (up ? a.ffn_w_up : a.ffn_w_gate) + (size_t)l * D * DFF;
            tr_item(src, DFF, DFF, 64 * kb, n0, (bf16*)(ws + WS_WGU) + (size_t)l * 2 * DFF * D, D, dr, 0, scr, lane, a.norm_ffn + l * D); continue; } r -= 4 * I_GU;
        { const int l = r / I_DN, q = r % I_DN, kb = q / 32, n0 = 32 * (q % 32);
            tr_item(a.ffn_w_down + (size_t)l * DFF * D, D, D, 64 * kb, n0, (bf16*)(ws + WS_WDN) + (size_t)l * D * DFF, DFF, n0, 0, scr, lane); }
    }
    for (int it = gw; it < 128 * 16; it += NGW) {
        const int cc = (it >> 4) * 4, n = (it & 15) * 64 + lane, g = cc >> 7;
        const float* pw = a.pool_w + (size_t)cc * 128; const float* ps = a.pool_scale + g * 128; const float* wo = a.w_out_ab + (size_t)(512 + g * 128) * D + n;
        float acc[4] = {0.f, 0.f, 0.f, 0.f};
#pragma unroll 32
        for (int d = 0; d < 128; ++d) { const float w = wo[(size_t)d * D] * ps[d];
#pragma unroll
            for (int j = 0; j < 4; ++j) acc[j] += pw[j * 128 + d] * w; }
        *(GAS u64*)((bf16*)(ws + WS_WOUT) + (size_t)n * D + 512 + cc) = (u64)pk2(acc[0], acc[1]) | ((u64)pk2(acc[2], acc[3]) << 32);
    }
    {
        f32x4 g4[4];
#pragma unroll
        for (int j = 0; j < 4; ++j) g4[j] = ((const GAS f32x4*)a.norm_mix)[lane + 64 * j];
        for (int m = gw; m < M; m += 4 * NGW) {
            f32x4 v[4][4];
#pragma unroll
            for (int r = 0; r < 4; ++r)
#pragma unroll
                for (int j = 0; j < 4; ++j) v[r][j] = ((const GAS f32x4*)(a.x + (size_t)(m + r * NGW < M ? m + r * NGW : m) * D))[lane + 64 * j];
#pragma unroll
            for (int r = 0; r < 4; ++r) { float sq = 0.f;
#pragma unroll
                for (int j = 0; j < 4; ++j) sq += (v[r][j].x * v[r][j].x + v[r][j].y * v[r][j].y) + (v[r][j].z * v[r][j].z + v[r][j].w * v[r][j].w);
                const float rr = 1.f / sqrtf(wave_sum_dpp(sq) * (1.f / D) + EPS);
                GAS u64* o8 = (GAS u64*)((bf16*)(ws + WS_XN) + (size_t)(m + r * NGW) * D) + lane;
                if (m + r * NGW < M)
#pragma unroll
                for (int j = 0; j < 4; ++j) o8[64 * j] = (u64)pk2(v[r][j].x * rr * g4[j].x, v[r][j].y * rr * g4[j].y) | ((u64)pk2(v[r][j].z * rr * g4[j].z, v[r][j].w * rr * g4[j].w) << 32); }
        }
    }
    for (int m = gw; m < 2 * MROWS; m += NGW) { const int l = m / MROWS, r = m % MROWS; rms_row_to_bf16(lane, a.mem + (size_t)r * D, a.norm_mem + l * D, (bf16*)(ws + WS_MEMN) + (size_t)m * D); }
}
constexpr int RSTD_OFF = LDSCTL_OFF + 1024, RSTD_MAX_UNITS = (LDS_BYTES - RSTD_OFF) / 1024;
__device__ __forceinline__ void fill_rstd(Frame& F, const pg8::StaticOrder& S, const float* ssq) {
    LAS float* tab = (LAS float*)(F.lds + RSTD_OFF); const int tid = otid(F.wave);
    if (tid < 256) {
        for (int i0 = 0; i0 < RSTD_MAX_UNITS; i0 += 4) {
            f32x4 p[4][4]; bool ok[4];
#pragma unroll
            for (int k = 0; k < 4; ++k) { pg8::Unit u; ok[k] = (i0 + k < RSTD_MAX_UNITS) && S.next(i0 + k, u); const int row = ok[k] ? u.pm * 256 + tid : tid;
#pragma unroll
                for (int j = 0; j < 4; ++j) p[k][j] = ((const f32x4*)(ssq + (size_t)row * 16))[j]; }
#pragma unroll
            for (int k = 0; k < 4; ++k) if (ok[k]) { float sm = 0.f;
#pragma unroll
                for (int j = 0; j < 4; ++j) sm += (p[k][j][0] + p[k][j][1]) + (p[k][j][2] + p[k][j][3]);
                tab[(i0 + k) * 256 + tid] = 1.0f / sqrtf(sm * (1.0f / 1024.0f) + EPS); }
            if (!ok[3]) break;
        }
    }
    __syncthreads();
}
__device__ const double ROPE_INV16[16] = { 0.15915494309189535, 0.0700865215877985, 0.03086376340470123, 0.013591370636193905, 0.005985185712713705, 0.002635675898667414, 0.001160663641240061, 0.0005111175045375439,
    0.00022507907903927653, 9.911730936901935e-05, 4.364795279280289e-05, 1.9221100684944863e-05, 8.464330808241401e-06, 3.727408601915352e-06, 1.6414262627950345e-06, 7.228293068832865e-07 };
__device__ __forceinline__ void rope_cs(int t, int d16, float& c, float& s) {
    const double rev = (double)t * ROPE_INV16[d16]; const float f = (float)(rev - __builtin_floor(rev));
    c = __builtin_amdgcn_cosf(f); s = __builtin_amdgcn_sinf(f);
}
struct P2Args { const float *a_q_norm, *a_k_norm, *cross_k_norm; unsigned char* ws; };
__device__ __forceinline__ float row16_sum(float v) {
#define R16_DPP(ctrl) v += __builtin_bit_cast(float, __builtin_amdgcn_update_dpp(0, __builtin_bit_cast(int, v), ctrl, 0xf, 0xf, true))
    R16_DPP(0xB1); R16_DPP(0x4E); R16_DPP(0x141); R16_DPP(0x140);
#undef R16_DPP
    return v;
}
__device__ __forceinline__ float quad_xor2(float v) { return __builtin_bit_cast(float, __builtin_amdgcn_update_dpp(0, __builtin_bit_cast(int, v), 0x4E, 0xf, 0xf, true)); }
__device__ __forceinline__ float quad_xor1(float v) { return __builtin_bit_cast(float, __builtin_amdgcn_update_dpp(0, __builtin_bit_cast(int, v), 0xB1, 0xf, 0xf, true)); }
__device__ __forceinline__ void p2b_rows4(unsigned char* ws, const float* q_norm, const float* k_norm, const int m0, const int lane) {
    const int l16 = lane & 15, e0 = l16 * 8, hq = lane >> 4, t0 = m0 & (T - 1);
    int zo = 0; asm volatile("" : "+s"(zo));
    {
        bf16* qb = (bf16*)(ws + WS_PROJ + (size_t)(0 + (hq >> 1)) * PROJ_T) + (size_t)m0 * 256 + (hq & 1) * 128 + e0;
        bf16* kb = (bf16*)(ws + WS_PROJ + (size_t)(2 + (hq >> 1)) * PROJ_T) + (size_t)m0 * 256 + (hq & 1) * 128 + e0;
        v4u uq[4], uk[4];
#pragma unroll
        for (int r = 0; r < 4; ++r) { uq[r] = *(const v4u*)(qb + r * 256); uk[r] = *(const v4u*)(kb + r * 256); }
        float gq[8], gk[8];
        { const f32x4 a0 = *(const f32x4*)(q_norm + e0), a1 = *(const f32x4*)(q_norm + e0 + 4), b0 = *(const f32x4*)(k_norm + e0), b1 = *(const f32x4*)(k_norm + e0 + 4);
#pragma unroll
          for (int j = 0; j < 4; ++j) { gq[j] = a0[j]; gq[4 + j] = a1[j]; gk[j] = b0[j]; gk[4 + j] = b1[j]; } }
        __builtin_amdgcn_sched_barrier(0);
#pragma unroll
        for (int r = 0; r < 4; ++r) {
            float cs[8], sn[8];
            if (l16 < 4) {
#pragma unroll
                for (int j = 0; j < 8; ++j) rope_cs(t0 + r, (l16 & 1) * 8 + j + zo, cs[j], sn[j]);
            }
#pragma unroll
            for (int it = 0; it < 2; ++it) {
                const v4u u = it ? uk[r] : uq[r]; float x[8] = {bf_lo(u.x), bf_hi(u.x), bf_lo(u.y), bf_hi(u.y), bf_lo(u.z), bf_hi(u.z), bf_lo(u.w), bf_hi(u.w)};
                float ss = 0.f;
#pragma unroll
                for (int j = 0; j < 8; ++j) ss += x[j] * x[j];
                ss = row16_sum(ss);
                const float rr = 1.f / sqrtf(ss * (1.f / 128.f) + EPS);
#pragma unroll
                for (int j = 0; j < 8; ++j) x[j] *= rr * (it ? gk[j] : gq[j]);
                float o[8];
#pragma unroll
                for (int j = 0; j < 8; ++j) o[j] = quad_xor2(x[j]);
                if (l16 < 2) {
#pragma unroll
                    for (int j = 0; j < 8; ++j) x[j] = x[j] * cs[j] - o[j] * sn[j]; }
                else if (l16 < 4) {
#pragma unroll
                    for (int j = 0; j < 8; ++j) x[j] = x[j] * cs[j] + o[j] * sn[j]; }
                *(v4u*)((it ? kb : qb) + r * 256) = (v4u){pk2(x[0], x[1]), pk2(x[2], x[3]), pk2(x[4], x[5]), pk2(x[6], x[7])};
            }
        }
    }
    __builtin_amdgcn_sched_barrier(0);
    {
        const bf16* up = (const bf16*)(ws + WS_PROJ + (size_t)(6 + (hq >> 1)) * PROJ_T) + (size_t)(m0 + 3) * 256 + (hq & 1) * 128 + e0;
        v4u uu[19];
#pragma unroll
        for (int j = 0; j < 19; ++j) uu[j] = *(const v4u*)(up - (ptrdiff_t)((t0 + 3 - j >= 0) ? j : 3) * 256);
        __builtin_amdgcn_sched_barrier(0);
        const int w = 2 << hq;
#pragma unroll
        for (int r = 0; r < 4; ++r) {
            const int cnt = (t0 + r + 1 < w) ? t0 + r + 1 : w; const float ic = 1.f / (float)cnt;
            float acc[8] = {0.f, 0.f, 0.f, 0.f, 0.f, 0.f, 0.f, 0.f}, sf[8];
#pragma unroll
            for (int j = 0; j < 16; ++j) { const v4u u = uu[3 - r + j];
                const float x[8] = {bf_lo(u.x), bf_hi(u.x), bf_lo(u.y), bf_hi(u.y), bf_lo(u.z), bf_hi(u.z), bf_lo(u.w), bf_hi(u.w)};
#pragma unroll
                for (int k = 0; k < 8; ++k) { acc[k] += (j < cnt) ? x[k] : 0.f; if (j == 0) sf[k] = x[k]; } }
            *(v4u*)((bf16*)(ws + WS_XN) + (size_t)(m0 + r) * 1024 + 512 + hq * 128 + e0) = (v4u){pk2(acc[0] * ic - sf[0], acc[1] * ic - sf[1]), pk2(acc[2] * ic - sf[2], acc[3] * ic - sf[3]),
                                                                                               pk2(acc[4] * ic - sf[4], acc[5] * ic - sf[5]), pk2(acc[6] * ic - sf[6], acc[7] * ic - sf[7])}; }
    }
}
__device__ __forceinline__ void p2_post(Frame& F, const P2Args& a) {
    const int gw = blockIdx.x * NWAVES + F.wave, NGW = F.G * NWAVES, lane = otid(F.wave) & 63;
    unsigned char* ws = a.ws;
    for (int m8 = gw; m8 < M / 8; m8 += NGW) {
        const int m = m8 * 8 + (lane >> 3), pc = lane & 7, t = m & (T - 1);
        const v4u u = *(const v4u*)((const bf16*)(ws + WS_PROJ + (size_t)12 * PROJ_T) + (size_t)m * 256 + 16 + pc * 8);
        float x[8] = {bf_lo(u.x), bf_hi(u.x), bf_lo(u.y), bf_hi(u.y), bf_lo(u.z), bf_hi(u.z), bf_lo(u.w), bf_hi(u.w)};
        float o[8];
#pragma unroll
        for (int j = 0; j < 8; ++j) o[j] = quad_xor1(x[j]);
        if (pc < 2) {
#pragma unroll
            for (int j = 0; j < 8; ++j) { float c, sn; rope_cs(t, 2 * j, c, sn); x[j] = pc ? (x[j] * c + o[j] * sn) : (x[j] * c - o[j] * sn); }
        }
        const v4u w = {pk2(x[0], x[1]), pk2(x[2], x[3]), pk2(x[4], x[5]), pk2(x[6], x[7])};
        *(v4u*)(ws + WS_IKT + (((size_t)(m >> 5) * 4 + (pc >> 1)) * 64 + (m & 31) + 32 * (pc & 1)) * 16) = w;
    }
    for (int it = gw; it < 2 * MROWS * 4; it += NGW) {
        const int l = it / (MROWS * 4), r = (it >> 2) % MROWS, h = it & 3;
        u64* p = (u64*)((bf16*)(ws + WS_MKV) + ((size_t)l * MROWS + r) * 2048 + h * 256) + lane;
        const u64 u = *p; float x0 = bf_lo((unsigned)u), x1 = bf_hi((unsigned)u), x2 = bf_lo((unsigned)(u >> 32)), x3 = bf_hi((unsigned)(u >> 32));
        const float rr = 1.f / sqrtf(wave_sum((x0 * x0 + x1 * x1) + (x2 * x2 + x3 * x3)) * (1.f / 256.f) + EPS);
        const f32x4 g = *(const f32x4*)(a.cross_k_norm + l * CHD + 4 * lane);
        *p = (u64)pk2(x0 * rr * g.x, x1 * rr * g.y) | ((u64)pk2(x2 * rr * g.z, x3 * rr * g.w) << 32);
    }
}

namespace d1s {
constexpr int CAP = 576, NE = CAP / 64, SB_BYTES = 4 * CAP * 4, IB_BYTES = 4 * CAP * 2, WAVE_BYTES = SB_BYTES + IB_BYTES + 1024 + 64;
static_assert(NWAVES * WAVE_BYTES <= RING_BYTES, "D1 LDS");
__device__ __forceinline__ unsigned f32_key(float f) { const unsigned u = __float_as_uint(f); return (u & 0x80000000u) ? ~u : (u | 0x80000000u); }
__device__ __forceinline__ float key_f32(unsigned k) { return __uint_as_float((k & 0x80000000u) ? (k ^ 0x80000000u) : ~k); }
__device__ __forceinline__ int mbcnt64(u64 m) { return (int)__builtin_amdgcn_mbcnt_hi((unsigned)(m >> 32), __builtin_amdgcn_mbcnt_lo((unsigned)m, 0u)); }
constexpr int KEEP_MAX = 320;
template <bool EXACT> __device__ __forceinline__ void select256(LAS float* sb, LAS unsigned short* ib, int& cnt, float& th, const int lane) {
    const int n = cnt; if (n <= TOPK) return;
    float v[NE]; unsigned key[NE]; unsigned id[NE];
#pragma unroll
    for (int i = 0; i < NE; ++i) { const int e = lane + 64 * i; v[i] = sb[e]; id[i] = ib[e]; key[i] = (e < n) ? f32_key(v[i]) : 0u; }
    unsigned prefix = 0u; int cur = n;
    for (int bit = 31; bit >= 0; --bit) {
        const unsigned test = prefix | (1u << bit); int c = 0;
#pragma unroll
        for (int i = 0; i < NE; ++i) c += __builtin_popcountll(__ballot(key[i] >= test));
        if (c >= TOPK) { prefix = test; cur = c; }
        if (!EXACT && cur <= KEEP_MAX) break;
    }
    const unsigned tau = prefix; int need = 1 << 30;
    if (EXACT) { int cgt = 0;
#pragma unroll
        for (int i = 0; i < NE; ++i) cgt += __builtin_popcountll(__ballot(key[i] > tau));
        need = TOPK - cgt; }
    int running = 0, ties = 0;
#pragma unroll
    for (int i = 0; i < NE; ++i) {
        bool keep;
        if (EXACT) { const u64 eq = __ballot(key[i] == tau); keep = (key[i] > tau) || (key[i] == tau && ties + mbcnt64(eq) < need); ties += __builtin_popcountll(eq); }
        else keep = key[i] >= tau;
        const u64 kb = __ballot(keep);
        if (keep) { const int pos = running + mbcnt64(kb); sb[pos] = v[i]; ib[pos] = (unsigned short)id[i]; }
        running += __builtin_popcountll(kb);
    }
    cnt = running; th = key_f32(tau);
}
__device__ __forceinline__ float relu1(float x) { const int i = __float_as_int(x); return __int_as_float(i > 0 ? i : 0); }
__device__ __forceinline__ void d1_block(LAS unsigned char* ldsw, const bf16* IQ, const bf16* IKW, const bf16* IKT, u64* BMb, int b, int q0, const int wave, const int lane, const bool pend, const unsigned vnext, volatile LAS unsigned* pslot) {
    const int r32 = lane & 31, hi = lane >> 5;
    LAS float* sbuf = (LAS float*)ldsw; LAS unsigned short* ibuf = (LAS unsigned short*)(ldsw + SB_BYTES); LAS unsigned* bmap = (LAS unsigned*)(ldsw + SB_BYTES + IB_BYTES);
    LAS int* cl = (LAS int*)(ldsw + SB_BYTES + IB_BYTES + 1024); LAS float* tl_ = (LAS float*)(cl + 4);
    const int head = ((r32 >> 3) << 2) + (r32 & 3);
    bf16x8 afr[2][4]; float wq[2][16]; int tl[2];
    const int nkt = (q0 >> 5) + 1;
    const bf16* kp = IKT + ((size_t)(b * T) >> 5) * 2048 + lane * 8;
    bf16x8 bq[4][4];
    v4u wraw[2][2];
#pragma unroll
    for (int rb = 0; rb < 2; ++rb) {
        const int tq = q0 + 4 * wave + 2 * rb + ((r32 >> 2) & 1);
        const bf16* ap = IQ + (size_t)(head >> 2) * ((size_t)M * 256) + (size_t)(b * T + tq) * 256 + (head & 3) * 64 + 8 * hi;
#pragma unroll
        for (int ks = 0; ks < 4; ++ks) afr[rb][ks] = *(const bf16x8*)(ap + ks * 16);
        tl[rb] = q0 + 4 * wave + 2 * rb + hi;
        const bf16* wp = IKW + (size_t)(b * T + tl[rb]) * 256;
        wraw[rb][0] = *(const v4u*)wp; wraw[rb][1] = *(const v4u*)(wp + 8);
    }
#pragma unroll
    for (int u = 0; u < 3; ++u) { const int k = u < nkt ? u : nkt - 1;
#pragma unroll
        for (int ks = 0; ks < 4; ++ks) bq[u][ks] = *(const bf16x8*)(kp + (size_t)k * 2048 + ks * 512); }
    __builtin_amdgcn_sched_barrier(0);
#pragma unroll
    for (int rb = 0; rb < 2; ++rb) {
        const int tq = q0 + 4 * wave + 2 * rb + ((r32 >> 2) & 1);
        {
            float x[8], o[8];
#pragma unroll
            for (int j = 0; j < 8; ++j) x[j] = __uint_as_float(((unsigned)(unsigned short)afr[rb][0][j]) << 16);
#pragma unroll
            for (int j = 0; j < 8; ++j) { const auto rr = __builtin_amdgcn_permlane32_swap(__float_as_uint(x[j]), __float_as_uint(x[j]), false, false); o[j] = __uint_as_float(hi ? rr[0] : rr[1]); }
#pragma unroll
            for (int j = 0; j < 8; ++j) { float c, sn; rope_cs(tq, 2 * j, c, sn); x[j] = hi ? (x[j] * c + o[j] * sn) : (x[j] * c - o[j] * sn); }
            const v4u w = {pk2(x[0], x[1]), pk2(x[2], x[3]), pk2(x[4], x[5]), pk2(x[6], x[7])};
            afr[rb][0] = __builtin_bit_cast(bf16x8, w);
        }
        const v4u w0 = wraw[rb][0], w1 = wraw[rb][1];
        const unsigned ww[8] = {w0.x, w0.y, w0.z, w0.w, w1.x, w1.y, w1.z, w1.w};
#pragma unroll
        for (int j = 0; j < 8; ++j) { wq[rb][2 * j] = bf_lo(ww[j]) * 0.03125f; wq[rb][2 * j + 1] = bf_hi(ww[j]) * 0.03125f; }
    }
    if (pend) { if (lane == 0) *pslot = vnext; }
    int cnt[2][2] = {{0, 0}, {0, 0}}; float thq[2][2] = {{-__builtin_inff(), -__builtin_inff()}, {-__builtin_inff(), -__builtin_inff()}};
    float thv[2] = {-__builtin_inff(), -__builtin_inff()};
    f32x16 accs[2][2];
    accs[0][0] = f32x16{}; accs[0][1] = f32x16{};
#pragma unroll
    for (int ks = 0; ks < 4; ++ks) accs[0][0] = __builtin_amdgcn_mfma_f32_32x32x16_bf16(afr[0][ks], bq[0][ks], accs[0][0], 0, 0, 0);
#pragma unroll
    for (int ks = 0; ks < 4; ++ks) accs[0][1] = __builtin_amdgcn_mfma_f32_32x32x16_bf16(afr[1][ks], bq[0][ks], accs[0][1], 0, 0, 0);
    for (int kt0 = 0; kt0 < nkt; kt0 += 4) {
#pragma unroll
        for (int u = 0; u < 4; ++u) {
            const int kt = kt0 + u; if (kt >= nkt) break;
            { const int k = kt + 3 < nkt ? kt + 3 : nkt - 1;
#pragma unroll
              for (int ks = 0; ks < 4; ++ks) bq[(u + 3) & 3][ks] = *(const bf16x8*)(kp + (size_t)k * 2048 + ks * 512); }
            const int skey = kt * 32 + r32;
            f32x16 accn0 = {}, accn1 = {};
#pragma unroll
            for (int ks = 0; ks < 4; ++ks) accn0 = __builtin_amdgcn_mfma_f32_32x32x16_bf16(afr[0][ks], bq[(u + 1) & 3][ks], accn0, 0, 0, 0);
#pragma unroll
            for (int ks = 0; ks < 4; ++ks) accn1 = __builtin_amdgcn_mfma_f32_32x32x16_bf16(afr[1][ks], bq[(u + 1) & 3][ks], accn1, 0, 0, 0);
            const f32x16 acc0 = accs[u & 1][0], acc1 = accs[u & 1][1];
            accs[(u + 1) & 1][0] = accn0; accs[(u + 1) & 1][1] = accn1;
            float sc[2];
            { float e0 = 0.f, e1 = 0.f;
#pragma unroll
              for (int j = 0; j < 16; ++j) { e0 = __builtin_fmaf(wq[0][j], relu1(acc0[j]), e0); e1 = __builtin_fmaf(wq[1][j], relu1(acc1[j]), e1); }
              sc[0] = e0; sc[1] = e1; }
#pragma unroll
            for (int rb = 0; rb < 2; ++rb) {
                float s = sc[rb];
                if (kt == nkt - 1) { asm volatile("" : "+v"(s)); s = (skey <= q0 + 4 * wave + 2 * rb + hi) ? s : -__builtin_inff(); }
                const bool pass = s > thv[rb];
                const u64 m = __builtin_amdgcn_fcmpf(s, thv[rb], 2  ); const unsigned mlo = (unsigned)m, mhi = (unsigned)(m >> 32);
                const int nlo = __builtin_popcount(mlo);
                const int pos = (int)__builtin_amdgcn_mbcnt_hi(mhi, __builtin_amdgcn_mbcnt_lo(mlo, 0u)) + (hi ? cnt[rb][1] - nlo : cnt[rb][0]);
                if (pass) { const int q = 2 * rb + hi; sbuf[q * CAP + pos] = s; ibuf[q * CAP + pos] = (unsigned short)skey; }
                cnt[rb][0] += nlo; cnt[rb][1] += __builtin_popcount(mhi);
            }
            const int cmax = max(max(cnt[0][0], cnt[0][1]), max(cnt[1][0], cnt[1][1]));
            if (cmax > CAP - 32) {
                if (lane == 0) { cl[0] = cnt[0][0]; cl[1] = cnt[0][1]; cl[2] = cnt[1][0]; cl[3] = cnt[1][1]; tl_[0] = thq[0][0]; tl_[1] = thq[0][1]; tl_[2] = thq[1][0]; tl_[3] = thq[1][1]; }
#pragma unroll 1
                for (int q = 0; q < 4; ++q) { int c = __builtin_amdgcn_readfirstlane(cl[q]);
                    if (c > CAP - 32) { float t_ = 0.f; select256<false>(sbuf + q * CAP, ibuf + q * CAP, c, t_, lane); if (lane == 0) { cl[q] = c; tl_[q] = t_; } } }
                cnt[0][0] = __builtin_amdgcn_readfirstlane(cl[0]); cnt[0][1] = __builtin_amdgcn_readfirstlane(cl[1]); cnt[1][0] = __builtin_amdgcn_readfirstlane(cl[2]); cnt[1][1] = __builtin_amdgcn_readfirstlane(cl[3]);
                thq[0][0] = tl_[0]; thq[0][1] = tl_[1]; thq[1][0] = tl_[2]; thq[1][1] = tl_[3];
                thv[0] = hi ? thq[0][1] : thq[0][0]; thv[1] = hi ? thq[1][1] : thq[1][0];
            }
        }
    }
    if (lane == 0) { cl[0] = cnt[0][0]; cl[1] = cnt[0][1]; cl[2] = cnt[1][0]; cl[3] = cnt[1][1]; }
#pragma unroll 1
    for (int q = 0; q < 4; ++q) {
        int n = __builtin_amdgcn_readfirstlane(cl[q]); float t_ = 0.f;
        select256<true>(sbuf + q * CAP, ibuf + q * CAP, n, t_, lane);
        const int t = q0 + 4 * wave + q;
        { unsigned z_ = 0u; asm volatile("" : "+v"(z_)); *(LAS v4u*)(bmap + 4 * lane) = (v4u){z_, z_, z_, z_}; }
#pragma unroll
        for (int i = 0; i < 4; ++i) { const int e = lane + 64 * i; if (e < n) { const unsigned id = ibuf[q * CAP + e]; __hip_atomic_fetch_or(bmap + (id >> 5), 1u << (id & 31), __ATOMIC_RELAXED, __HIP_MEMORY_SCOPE_WORKGROUP); } }
        const u64 w0 = *(LAS u64*)(bmap + 2 * lane), w1 = *(LAS u64*)(bmap + 128 + 2 * lane);
        BMb[(size_t)lane * T + t] = w0; BMb[(size_t)(64 + lane) * T + t] = w1;
    }
    {
        const float* const volatile __attribute__((address_space(4)))* kin_ = (const float* const volatile __attribute__((address_space(4)))*)__builtin_amdgcn_kernarg_segment_ptr();
        p2b_rows4((unsigned char*)kin_[29], kin_[7], kin_[8], b * T + q0 + 4 * wave, otid(wave) & 63); }
}
constexpr int D1_SLOTS = 128;
__device__ __forceinline__ void d1_phase(Frame& F, unsigned char* ws) {
    const bf16* IQ = (const bf16*)(ws + WS_PROJ + 8 * PROJ_T); const bf16* IKW = (const bf16*)(ws + WS_PROJ + 12 * PROJ_T);
    const int lane = otid(F.wave) & 63;
    LAS unsigned char* ldsw = F.lds + RING_OFF + F.wave * WAVE_BYTES;
    volatile LAS unsigned* tk = F.MISC + 32;
    unsigned* ctr = (unsigned*)(F.ctl + CW_D1Q);
    const unsigned NB = BATCH * 256;
    for (int k = 0; k < D1_SLOTS - 1; ++k) {
        unsigned t = blockIdx.x;
        if (k > 0) {
            unsigned v = 2u + NB;
            if (lane == 0) { v = tk[k]; while (v < 2u) { __builtin_amdgcn_s_sleep(2); v = tk[k]; } }
            t = (unsigned)__builtin_amdgcn_readfirstlane((int)v) - 2u;
        }
        if (t >= NB) break;
        bool pend = false; unsigned vnext = 0u;
        if (lane == 0) { unsigned expect = 0u;
            if (tk[k + 1] == 0u && __hip_atomic_compare_exchange_strong((LAS unsigned*)(tk + k + 1), &expect, 1u, __ATOMIC_RELAXED, __ATOMIC_RELAXED, __HIP_MEMORY_SCOPE_WORKGROUP)) {
                vnext = __hip_atomic_fetch_add(ctr, 1u, __ATOMIC_RELAXED, __HIP_MEMORY_SCOPE_AGENT) + F.G + 2u; pend = true; } }
        const int b = t & 3, p = 255 - (int)(t >> 2); u64* BMb = (u64*)(ws + WS_BM) + (size_t)b * 128 * T;
        if ((k ^ (F.wave >> 2)) & 1) __builtin_amdgcn_s_setprio(1); else __builtin_amdgcn_s_setprio(0);
        d1_block(ldsw, IQ, IKW, (const bf16*)(ws + WS_IKT), BMb, b, 32 * p, F.wave, otid(F.wave) & 63  , pend, vnext, tk + k + 1);
    }
    __builtin_amdgcn_s_setprio(0);
}
}
namespace xat {
using namespace dsa2;
#define XK(row, colB) ((row) * 512 + ((colB) ^ (((row) & 7) << 4)))
constexpr int XSCR = RING_BYTES + 1024;
__device__ __forceinline__ void cross_unit(const bf16* CQ, const bf16* MKVl, const float* qgain, bf16* CO, int b, int h, int qb, char* lds, const int wave_) {
    const int tid = otid(wave_);
    const int wid = wave_, lane = tid & 63, r32 = lane & 31, hi = lane >> 5;
    float* wsx = (float*)(lds + XSCR) + wid * 64; float* li_l = wsx, * al_l = wsx + 32;
    const size_t row = (size_t)b * ::T + qb * 256 + wid * 32 + r32;
    const bf16* Kg = MKVl + (size_t)(b * MEML) * 2048 + h * CHD; const bf16* Vg = Kg + 1024;
    constexpr float XSCALE = 0.0625f;
    LAS unsigned char* ldsL = (LAS unsigned char*)(LAS char*)lds;
    unsigned koff[4], voff[2];
#pragma unroll
    for (int j = 0; j < 4; ++j) { const int p = wid + 8 * j, kr = 2 * p + (lane >> 5), cc = (lane & 31) ^ (kr & 7); koff[j] = (unsigned)(kr * 2048 + cc * 8); }
#pragma unroll
    for (int j = 0; j < 2; ++j) { const int p = wid + 8 * j, sub = 2 * p + (lane >> 5), kk = (sub >> 2) * 8 + ((lane & 31) >> 2), k = (kk & ~0xC) | ((kk & 4) << 1) | ((kk & 8) >> 1), c = (sub & 3) * 32 + (lane & 3) * 8; voff[j] = (unsigned)(k * 2048 + c); }
#define X_DMAK(t) do { _Pragma("unroll") for (int j_ = 0; j_ < 4; ++j_) __builtin_amdgcn_global_load_lds((const unsigned*)(Kg + (size_t)(t) * 64 * 2048 + koff[j_]), (LAS unsigned*)(ldsL + (t) * 32768 + (wid + 8 * j_) * 1024), 16, 0, 0); } while (0)
#define X_DMAV(t) do { _Pragma("unroll") for (int hf_ = 0; hf_ < 2; ++hf_) _Pragma("unroll") for (int j_ = 0; j_ < 2; ++j_) \
        __builtin_amdgcn_global_load_lds((const unsigned*)(Vg + (size_t)(t) * 64 * 2048 + hf_ * 128 + voff[j_]), (LAS unsigned*)(ldsL + (t) * 32768 + hf_ * 16384 + (wid + 8 * j_) * 1024), 16, 0, 0); } while (0)
#define X_WAIT(n) do { asm volatile("s_waitcnt vmcnt(" #n ")" ::: "memory"); __syncthreads(); } while (0)
    bf16x8 qr[16]; float ss = 0.f;
    const bf16* qp = CQ + row * ::D + h * CHD + 8 * hi;
#pragma unroll
    for (int d0 = 0; d0 < 16; ++d0) qr[d0] = *(const bf16x8*)(qp + d0 * 16);
    __syncthreads();
    X_DMAK(0); X_DMAK(1); X_DMAK(2); X_DMAK(3);
#pragma unroll
    for (int d0 = 0; d0 < 16; ++d0) {
#pragma unroll
        for (int j = 0; j < 8; ++j) { const float x = __uint_as_float(((unsigned)(unsigned short)qr[d0][j]) << 16); ss += x * x; } }
    ss += __shfl_xor(ss, 32);
    const float rn = 1.f / sqrtf(ss * (1.f / 256.f) + EPS);
    const float* qgl = (const float*)(lds + XSCR + 2048);
#pragma unroll
    for (int d0 = 0; d0 < 16; ++d0) { const f32x4 g0 = *(const f32x4*)(qgl + d0 * 16 + 8 * hi), g1 = *(const f32x4*)(qgl + d0 * 16 + 8 * hi + 4);
        f32x4 a, c;
#pragma unroll
        for (int j = 0; j < 4; ++j) { a[j] = __uint_as_float(((unsigned)(unsigned short)qr[d0][j]) << 16) * rn * g0[j]; c[j] = __uint_as_float(((unsigned)(unsigned short)qr[d0][4 + j]) << 16) * rn * g1[j]; }
        qr[d0] = pack8(a, c); }
    const int vb0 = (int)(uintptr_t)lds + v_rd_base(lane);
    float m_reg = -1e30f, l_reg = 0.f;
    float alq[4]; bf16x8 pall[16];
    X_WAIT(12);
#define X_STEPA(t) do { \
        if ((t) > 0) X_DMAV((t) - 1);                        \
        f32x16 p0 = {}, p1 = {}; \
        const char* kb[4]; \
        _Pragma("unroll") for (int dd = 0; dd < 4; ++dd) kb[dd] = lds + (t) * 32768 + XK(r32, dd * 32 + hi * 16); \
        _Pragma("unroll") for (int d0 = 0; d0 < 16; ++d0) { const char* ka = kb[d0 & 3] + (d0 >> 2) * 128; \
            const bf16x8 k0 = *(const bf16x8*)ka; const bf16x8 k1 = *(const bf16x8*)(ka + 32 * 512); \
            p0 = __builtin_amdgcn_mfma_f32_32x32x16_bf16(k0, qr[d0], p0, 0, 0, 0); p1 = __builtin_amdgcn_mfma_f32_32x32x16_bf16(k1, qr[d0], p1, 0, 0, 0); } \
        float mn, alpha; \
        partialSM_s(p0, p1, m_reg, mn, alpha, XSCALE); finishSM(p0, p1, alpha, l_reg, pall[4 * (t)], pall[4 * (t) + 1], pall[4 * (t) + 2], pall[4 * (t) + 3]); \
        alq[t] = alpha; \
        if ((t) == 3) { if (hi == 0) li_l[r32] = l_reg; } \
        X_WAIT(8); } while (0)
    X_STEPA(0); X_STEPA(1); X_STEPA(2); X_STEPA(3);
    f32x16 o[8];
#pragma unroll
    for (int d_ = 0; d_ < 8; ++d_) o[d_] = f32x16{};
#define X_RESC(alpha) do { if (__any((alpha) < 1.f)) { if (hi == 0) al_l[r32] = (alpha); asm volatile("s_waitcnt lgkmcnt(0)" ::: "memory"); \
            _Pragma("unroll") for (int d_ = 0; d_ < 8; ++d_) _Pragma("unroll") for (int r = 0; r < 16; ++r) o[d_][r] *= al_l[crow(r, hi)]; } } while (0)
#define X_STEPB(t, NW) do { \
        if ((t) == 0) X_DMAV(3);                              \
        else X_RESC(alq[t]); \
        pv_tile<0, false>(o, vb0 + (t) * 32768, pall[4 * (t)], pall[4 * (t) + 1], pall[4 * (t) + 2], pall[4 * (t) + 3], true); \
        pv_tile<0, false>(o + 4, vb0 + (t) * 32768 + 16384, pall[4 * (t)], pall[4 * (t) + 1], pall[4 * (t) + 2], pall[4 * (t) + 3], true); \
        if ((t) < 3) X_WAIT(NW); } while (0)
    X_STEPB(0, 8); X_STEPB(1, 4); X_STEPB(2, 0); X_STEPB(3, 0);
    asm volatile("s_waitcnt lgkmcnt(0)" ::: "memory");
    { bf16* Ow = CO + ((size_t)b * ::T + qb * 256 + wid * 32) * ::D + h * CHD;
#pragma unroll
      for (int r = 0; r < 16; ++r) { const int orow = crow(r, hi); const float rl = __builtin_amdgcn_rcpf(li_l[orow]);
#pragma unroll
          for (int d0 = 0; d0 < 8; ++d0) { const float v = o[d0][r] * rl; const float vn = __shfl_xor(v, 1);
              if ((r32 & 1) == 0) *(unsigned*)(Ow + (size_t)orow * ::D + d0 * 32 + r32) = cvtpk(v, vn); } } }
#undef X_STEPA
#undef X_STEPB
#undef X_RESC
#undef X_WAIT
#undef X_DMAK
#undef X_DMAV
}
#undef XK
__device__ __forceinline__ void cross_phase(Frame& F, char* lds, const bf16* CQ, const bf16* MKVl, const float* qgain, bf16* CO, const int rev, unsigned char* ws) {
    { const int t_ = otid(F.wave); if (t_ < CHD) ((float*)(lds + XSCR + 2048))[t_] = qgain[t_]; }
    __syncthreads();
    if (F.G == 256) {
        const int c = obid(), x = c & 7, r = c >> 3;
        for (int k = 0; k < 2; ++k) { const int j = r + 32 * (k ^ rev), panel = 16 * x + (j >> 2), h = j & 3;
            cross_unit(CQ, MKVl, qgain, CO, panel >> 5, h, panel & 31, lds, F.wave); }
    } else {
        for (int u = blockIdx.x; u < BATCH * 4 * (::T / 256); u += F.G) {
            const int qb = u & 31, h = (u >> 5) & 3, b = u >> 7;
            cross_unit(CQ, MKVl, qgain, CO, b, h, qb, lds, F.wave);
        }
    }
}
}

namespace dsa2 {
typedef unsigned short TI;
__device__ __forceinline__ BlockRef<TI, TI> d2_ref(unsigned char* ws, int bh, int qb) {
    const int b = bh >> 2, h = bh & 3; BlockRef<TI, TI> r;
    const size_t rowq = (size_t)b * ::T + (size_t)qb * QB, rowk = (size_t)b * ::T;
    r.Q = (const TI*)(ws + WS_PROJ + (size_t)(0 + (h >> 1)) * PROJ_T) + rowq * LDQ + (h & 1) * 128;
    r.K = (const TI*)(ws + WS_PROJ + (size_t)(2 + (h >> 1)) * PROJ_T) + rowk * LDQ + (h & 1) * 128;
    r.V = (const TI*)(ws + WS_PROJ + (size_t)(4 + (h >> 1)) * PROJ_T) + rowk * LDQ + (h & 1) * 128;
    r.O = (TI*)(ws + WS_XN) + rowq * LDO + h * 128;
    r.MW = (const unsigned long long*)(ws + WS_BM) + (size_t)b * 128 * ::T;
    r.P0 = qb * QB; return r;
}
__device__ __forceinline__ void d2_phase(char* lds, unsigned char* ws, int G, const int wave_) {
    constexpr int nqb = ::T / QB, nx = nqb / 2, total = nx * BATCH * 4;
    int L = blockIdx.x; if (L >= total) return;
    int bh = L / nx, x = L % nx, pass = 0;
    BlockRef<TI, TI> cur = d2_ref(ws, bh, x);
    Seam<TI> S;
    causal_swa_prime<TI, TI>(cur, ::T, lds, S, wave_);
    for (;;) {
        const bool more_pass = pass == 0, more_item = L + G < total, last = !more_pass && !more_item;
        int Ln = L, passn = pass + 1, bhn = bh, xn = x;
        if (!more_pass) { passn = 0; Ln = more_item ? L + G : L; bhn = Ln / nx; xn = Ln % nx; }
        const BlockRef<TI, TI> nxt = last ? cur : d2_ref(ws, bhn, passn ? nqb - 1 - xn : xn);
        causal_swa_block<TI, TI>(cur, nxt, ::T, ::T, lds, S, wave_);
        if (last) break;
        cur = nxt; L = Ln; pass = passn; bh = bhn; x = xn;
    }
}
}

__device__ __forceinline__ void conv_phase(Frame& F, char* lds, const bf16* Gin, const float* dw_w, const float* dw_b, const float* ln_g, const float* ln_b, bf16* OUT) {
    const int tid = otid(F.wave);
    const int lane = tid & 63, wave = F.wave;
    pg8::f32x2 wv[CW];
#pragma unroll
    for (int j = 0; j < CW; ++j) { const float2 v = *(const float2*)(dw_w + j * D + 2 * tid); wv[j] = (pg8::f32x2){v.x, v.y}; }
#pragma unroll
    for (int j = 0; j < CW; ++j) asm volatile("" : "+v"(wv[j]));
    const float2 bias = *(const float2*)(dw_b + 2 * tid), lg = *(const float2*)(ln_g + 2 * tid), lb = *(const float2*)(ln_b + 2 * tid);
    float* red = (float*)lds; float* stat = red + 512;
    const GAS unsigned* G32 = (const GAS unsigned*)Gin; GAS unsigned* O32 = (GAS unsigned*)OUT;
    const int cvb = obid(), cv0 = F.G == 256 ? 128 * (cvb & 7) + (cvb >> 3) : cvb, cvs = F.G == 256 ? 32 : F.G, cvn = F.G == 256 ? 128 * (cvb & 7) + 128 : M / 32;
    for (int tile = cv0; tile < cvn; tile += cvs) {
        const int row0 = tile * 32, t0 = row0 & (T - 1);
        pg8::f32x2 av[32];
#pragma unroll
        for (int r = 0; r < 32; ++r) av[r] = (pg8::f32x2){bias.x, bias.y};
        const GAS unsigned* gp = G32 + ((ptrdiff_t)row0 - (CW - 1)) * 512 + tid;
        constexpr int CPF = 16;
        unsigned ring[CPF];
#pragma unroll
        for (int k = 0; k < CPF; ++k) {
            asm volatile("" : "+v"(gp));
            const bool ok = (t0 - (CW - 1) + k >= 0);
            const GAS unsigned* gcur = ok ? gp : (G32 + tid); gp += 512; ring[k] = *gcur; }
        __builtin_amdgcn_sched_barrier(0);
#pragma unroll
        for (int i = -(CW - 1); i < 32; ++i) {
            unsigned u = ring[(i + CW - 1) % CPF]; u = (t0 + i >= 0) ? u : 0u; const pg8::f32x2 xv = {bf_lo(u), bf_hi(u)};
            if (i + CPF < 32) {
                asm volatile("" : "+v"(gp));
                const bool ok = (t0 + i + CPF >= 0);
                const GAS unsigned* gcur = ok ? gp : (G32 + tid); gp += 512; ring[(i + CW - 1) % CPF] = *gcur; }
#pragma unroll
            for (int r = (i < 0 ? 0 : i); r <= (i + CW - 1 > 31 ? 31 : i + CW - 1); ++r) av[r] = __builtin_elementwise_fma(wv[i + CW - 1 - r], xv, av[r]);
        }
#pragma unroll
        for (int r = 0; r < 32; ++r) { const float s = wave_sum_dpp(av[r].x + av[r].y), q = wave_sum_dpp(av[r].x * av[r].x + av[r].y * av[r].y); if (lane == 0) { red[(r * 8 + wave) * 2] = s; red[(r * 8 + wave) * 2 + 1] = q; } }
        __syncthreads();
        if (tid < 32) { float s = 0.f, q = 0.f;
#pragma unroll
            for (int k = 0; k < 8; ++k) { s += red[(tid * 8 + k) * 2]; q += red[(tid * 8 + k) * 2 + 1]; }
            const float mean = s * (1.f / D), var = fmaxf(q * (1.f / D) - mean * mean, 0.f);
            stat[2 * tid] = mean; stat[2 * tid + 1] = 1.f / sqrtf(var + EPS); }
        __syncthreads();
#pragma unroll
        for (int r = 0; r < 32; ++r) { const float mean = stat[2 * r], rstd = stat[2 * r + 1];
            float y0 = (av[r].x - mean) * rstd * lg.x + lb.x, y1 = (av[r].y - mean) * rstd * lg.y + lb.y;
            y0 = y0 * __builtin_amdgcn_rcpf(1.f + __builtin_amdgcn_exp2f(-1.4426950408889634f * y0)); y1 = y1 * __builtin_amdgcn_rcpf(1.f + __builtin_amdgcn_exp2f(-1.4426950408889634f * y1));
            O32[(size_t)(row0 + r) * 512 + tid] = pk2(y0, y1); }
        __syncthreads();
    }
}

constexpr int NPHASE = 28;
struct Args { const float* in[28]; float* out; unsigned char* ws; int ph_lo, ph_hi; };
__device__ __forceinline__ int osel(int l, int v0, int v1) { int r = __builtin_amdgcn_readfirstlane(v0 + l * (v1 - v0)); asm volatile("" : "+s"(r)); return r; }
template <int LO, int HI> __global__ void __launch_bounds__(NWAVES * 64, 2) trunk_fwd(Args args) {
    extern __shared__ __attribute__((aligned(16))) unsigned char lds[];
    Frame F;
    F.lds = (LAS unsigned char*)lds;
    F.MISC = (volatile LAS unsigned*)(F.lds + MISC_OFF);
    F.wave = __builtin_amdgcn_readfirstlane(threadIdx.x >> 6); F.tid = 0; F.lane = 0;
    F.G = gridDim.x;
    unsigned char* ws = args.ws;
    F.ctl = (gu32*)(ws + WS_CTL);
    for (int u = otid(F.wave); u < (LDS_BYTES - LDSCTL_OFF) / 4; u += NWAVES * 64) ((LAS unsigned*)(F.lds + LDSCTL_OFF))[u] = 0u;
    __syncthreads();
    XcdBarrier bar; bar.wave = F.wave; bar.bar = (unsigned*)(F.ctl + CW_BAR); bar.x = 0; bar.st = nullptr;
    if (!MK_PER_PHASE) { bar = xcd_barrier_post((unsigned*)(F.ctl + CW_BAR), F.MISC + 8, F.wave);
        if (F.wave == 0 && lane_id_() == 0 && (bar.x != (unsigned)(blockIdx.x & 7) || gridDim.x != 256u)) (void)xb_add((unsigned*)(F.ctl + CW_MIS), 1u); }
    constexpr int lo = LO, hi = HI;
#ifdef ONLY_PHASE
#define IN(k) (((k) == ONLY_PHASE || ((k) >= 17 && (k) - 11 == ONLY_PHASE)) && lo <= (k) && (k) < hi)
#else
#define IN(k) (lo <= (k) && (k) < hi)
#endif
#define SEAM(k) do { if (!MK_PER_PHASE && (k) + 1 < hi) xcd_barrier(bar); } while (0)
#define SEAM_L(k) do { if (!MK_PER_PHASE && (k) + 1 < hi) { if (F.MISC[10]) xcd_barrier_local(bar); else xcd_barrier(bar); } } while (0)
    const float* const volatile __attribute__((address_space(4)))* kin = (const float* const volatile __attribute__((address_space(4)))*)__builtin_amdgcn_kernarg_segment_ptr();
#define INP(i) (kin[i])
    float* H = args.out;
    bf16* XN = (bf16*)(ws + WS_XN);

    if (IN(0)) {
        P0Args a{INP(3), INP(5), INP(0), INP(1), INP(2), INP(4), INP(6), INP(9), INP(10), INP(11), INP(12), INP(18), INP(19), INP(20), INP(21), INP(24), INP(25), INP(26), INP(27), ws};
        p0_prologue(F, a); SEAM(0);
        if (!MK_PER_PHASE) {
            if (F.wave == 0 && lane_id_() == 0) F.MISC[10] = (xb_ld((unsigned*)(F.ctl + CW_MIS)) == 0u) ? 1u : 0u;
            __syncthreads(); }
    }
    if (IN(1)) {
        { pg8::Gemm g{XN, (const bf16*)(ws + WS_WIN), M, NINP, D}; pg8::StaticOrder S; S.init(M, NINP, F.G, obid());
          pg8::EpiBf16<0, false, true> E{(bf16*)(ws + WS_PROJ), 256, nullptr, 256, (size_t)M * 256, 1.f, nullptr};
          pg8::gemm_phase<pg8::EpiBf16<0, false, true>, pg8::StaticOrder, true, true>(F.lds + RING_OFF, g, S, E, F.wave); }
        for (int l = 0; l < 2; ++l) {
          pg8::Gemm g{(const bf16*)(ws + WS_MEMN) + (size_t)l * MROWS * D, (const bf16*)(ws + WS_WCKV) + (size_t)l * 2 * D * D, MROWS, 2 * D, D}; pg8::StaticOrder S; S.init(MROWS, 2 * D, F.G, (int)((blockIdx.x + 128 - 32 * l) % F.G));
          pg8::EpiBf16<0, false, true> E{(bf16*)(ws + WS_MKV) + (size_t)l * MROWS * 2 * D, 2 * D, nullptr, 0, 0, 1.f, nullptr};
          pg8::gemm_phase<pg8::EpiBf16<0, false, true>, pg8::StaticOrder, true, true>(F.lds + RING_OFF, g, S, E, F.wave); }
        SEAM(1);
    }
    if (IN(2)) { P2Args a{INP(7), INP(8), INP(23), ws}; p2_post(F, a); SEAM(2); }
    if (IN(3)) { d1s::d1_phase(F, ws); SEAM(3); }
    if (IN(4)) { if (F.wave >> 2) __builtin_amdgcn_s_setprio(1);
                 dsa2::d2_phase((char*)lds + RING_OFF, ws, F.G, F.wave); __builtin_amdgcn_s_setprio(0); SEAM(4); }
    bf16* HB2 = (bf16*)(ws + WS_HB2);
    bf16* CQb = (bf16*)H; bf16* COb = CQb + (size_t)M * D;
    if (IN(5)) {
        pg8::Gemm g{XN, (const bf16*)(ws + WS_WOUT), M, D, D}; pg8::StaticOrder S; S.init(M, D, F.G, obid());
        pg8::EpiRes2<true> E{INP(0), nullptr, HB2, (float*)(ws + WS_SSQ), D};
        pg8::gemm_phase<pg8::EpiRes2<true>, pg8::StaticOrder, true, true>(F.lds + RING_OFF, g, S, E, F.wave); SEAM_L(5);
    }
#if MK_PER_PHASE
#pragma unroll
#else
#pragma unroll 1
#endif
    for (int l_it = 0; l_it < 2; ++l_it) {
        int l = l_it; asm volatile("" : "+s"(l));
        const int pb = 6 + 11 * l_it;
        float* ssq_cq = (float*)(ws + WS_SSQ + (size_t)(3 * l) * SSQ_BYTES); float* ssq_ffn = (float*)(ws + WS_SSQ + (size_t)(3 * l + 1) * SSQ_BYTES); float* ssq_dn = (float*)(ws + WS_SSQ + 2 * SSQ_BYTES);
        if (l == 1) {
            if (IN(pb + 1)) {
                pg8::Gemm g{HB2, (const bf16*)(ws + WS_WCIN), M, 2 * D, D}; pg8::StaticOrder S; S.init(M, 2 * D, F.G, obid());
                fill_rstd(F, S, ssq_dn);
                pg8::EpiGate<1> E{COb, D, INP(13), D, (const LAS float*)(F.lds + RSTD_OFF)};
                pg8::gemm_phase<pg8::EpiGate<1>, pg8::StaticOrder, true, true>(F.lds + RING_OFF, g, S, E, F.wave); SEAM(pb + 1);
            }
            if (IN(pb + 2)) { conv_phase(F, (char*)lds + RING_OFF, COb, INP(14), INP(15), INP(16), INP(17), XN); SEAM(pb + 2); }
            if (IN(pb + 3)) {
                pg8::Gemm g{XN, (const bf16*)(ws + WS_WCOUT), M, D, D}; pg8::StaticOrder S; S.init(M, D, F.G, obid(), 1);
                pg8::EpiRes2<false> E{HB2, nullptr, HB2, ssq_cq, D};
                pg8::gemm_phase<pg8::EpiRes2<false>, pg8::StaticOrder, true, true>(F.lds + RING_OFF, g, S, E, F.wave); SEAM_L(pb + 3);
            }
        }
        if (IN(pb + 5)) {
            pg8::Gemm g{HB2, (const bf16*)(ws + WS_WCQ) + (size_t)l * D * D, M, D, D}; pg8::StaticOrder S; S.init(M, D, F.G, obid(), osel(l, 1, 0));
            pg8::EpiBf16<0> E{CQb, D, nullptr, 0, 0, 1.f, nullptr};
            pg8::gemm_phase<pg8::EpiBf16<0>, pg8::StaticOrder, true, true>(F.lds + RING_OFF, g, S, E, F.wave); SEAM_L(pb + 5);
        }
        if (IN(pb + 6)) { xat::cross_phase(F, (char*)lds + RING_OFF, CQb, (const bf16*)(ws + WS_MKV) + (size_t)l * MROWS * 2 * D, INP(22) + l * CHD, COb, osel(l, 0, 1), ws); SEAM_L(pb + 6); }
        if (IN(pb + 7)) {
            pg8::Gemm g{COb, (const bf16*)(ws + WS_WCO) + (size_t)l * D * D, M, D, D}; pg8::StaticOrder S; S.init(M, D, F.G, obid(), osel(l, 1, 0));
            pg8::EpiRes2<false> E{HB2, nullptr, XN, ssq_ffn, D};
            pg8::gemm_phase<pg8::EpiRes2<false>, pg8::StaticOrder, true, true>(F.lds + RING_OFF, g, S, E, F.wave); SEAM_L(pb + 7);
        }
        if (IN(pb + 9)) {
            pg8::Gemm g{XN, (const bf16*)(ws + WS_WGU) + (size_t)l * 2 * DFF * D, M, 2 * DFF, D}; pg8::StaticOrder S; S.init(M, 2 * DFF, F.G, obid(), osel(l, 0, 1));
            fill_rstd(F, S, ssq_ffn);
            pg8::EpiGate<0> E{(bf16*)(ws + WS_HID), DFF, nullptr, 0, (const LAS float*)(F.lds + RSTD_OFF)};
            pg8::gemm_phase<pg8::EpiGate<0>, pg8::StaticOrder, true, true>(F.lds + RING_OFF, g, S, E, F.wave); if (l == 0) SEAM_L(pb + 9); else SEAM(pb + 9);
        }
        if (IN(pb + 10)) {
            pg8::Gemm g{(const bf16*)(ws + WS_HID), (const bf16*)(ws + WS_WDN) + (size_t)l * D * DFF, M, D, DFF}; pg8::StaticOrder S; S.init(M, D, F.G, obid(), osel(l, 1, 0));
            pg8::EpiRes2<false> E{XN, l ? H : nullptr, HB2, ssq_dn, D};
            pg8::gemm_phase<pg8::EpiRes2<false>, pg8::StaticOrder, true, true>(F.lds + RING_OFF, g, S, E, F.wave); SEAM_L(pb + 10);
        }
    }
#undef IN
#undef SEAM
}

extern "C" void kernel_launch(void* const* d_in, const int* in_sizes, int n_in, void* d_out, int out_size, void* d_ws, size_t ws_size, hipStream_t stream) {
    static int grid = 0;
    if (grid == 0) {
        if (n_in != 28 || in_sizes[0] != M * D || out_size != M * D || ws_size < WS_END) { fprintf(stderr, "kernel_launch: unexpected shapes (n_in %d, in0 %d, out %d, ws %zu)\n", n_in, n_in > 0 ? in_sizes[0] : -1, out_size, ws_size); grid = -1; return; }
        int dev = 0, cus = 0, per_cu = 0;
        if (hipGetDevice(&dev) != hipSuccess || hipDeviceGetAttribute(&cus, hipDeviceAttributeMultiprocessorCount, dev) != hipSuccess) { grid = -1; return; }
#if !MK_PER_PHASE
        if (hipFuncSetAttribute((const void*)trunk_fwd<0, NPHASE>, hipFuncAttributeMaxDynamicSharedMemorySize, LDS_BYTES) != hipSuccess) { fprintf(stderr, "kernel_launch: hipFuncSetAttribute failed\n"); grid = -1; return; }
        if (hipOccupancyMaxActiveBlocksPerMultiprocessor(&per_cu, (const void*)trunk_fwd<0, NPHASE>, NWAVES * 64, LDS_BYTES) != hipSuccess || per_cu < 1) fprintf(stderr, "kernel_launch: note: occupancy query reports %d workgroups per CU\n", per_cu);
#endif
        (void)hipGetLastError();
        grid = cus > 256 ? 256 : cus;
    }
    if (grid < 0) return;
    if (hipMemsetAsync((char*)d_ws + WS_CTL, 0, CTL_ZERO_BYTES, stream) != hipSuccess) return;
    Args a{};
    for (int i = 0; i < 28; ++i) a.in[i] = (const float*)d_in[i];
    a.out = (float*)d_out; a.ws = (unsigned char*)d_ws;
#if MK_PER_PHASE
#define LAUNCH_PH(p) do { static bool attr_ = false; if (!attr_) { (void)hipFuncSetAttribute((const void*)trunk_fwd<p, p + 1>, hipFuncAttributeMaxDynamicSharedMemorySize, LDS_BYTES); attr_ = true; } \
        hipLaunchKernelGGL((trunk_fwd<p, p + 1>), dim3(grid), dim3(NWAVES * 64), LDS_BYTES, stream, a); } while (0)
    LAUNCH_PH(0); LAUNCH_PH(1); LAUNCH_PH(2); LAUNCH_PH(3); LAUNCH_PH(4); LAUNCH_PH(5);
    LAUNCH_PH(11); LAUNCH_PH(12); LAUNCH_PH(13); LAUNCH_PH(15); LAUNCH_PH(16);
    LAUNCH_PH(18); LAUNCH_PH(19); LAUNCH_PH(20); LAUNCH_PH(22); LAUNCH_PH(23); LAUNCH_PH(24); LAUNCH_PH(26); LAUNCH_PH(27);
#else
    hipLaunchKernelGGL((trunk_fwd<0, NPHASE>), dim3(grid), dim3(NWAVES * 64), LDS_BYTES, stream, a);
#endif
}
```
